# Optimizing an MI355X kernel written in HIP

```python
import jax, jax.numpy as jnp
from jax import lax
import numpy as np

D_MODEL = 4096
BATCH = 1
SEQ = 16384
DEPTH = 4

N_MIXERS = 2
N_ATTN_LAYERS = (DEPTH + N_MIXERS - 1) // N_MIXERS
N_POOL_LAYERS = DEPTH // N_MIXERS
HEAD_DIM = 128
N_HEADS = D_MODEL // HEAD_DIM
N_KV = 8
GROUP = N_HEADS // N_KV
Q_W = N_HEADS * HEAD_DIM
KV_W = N_KV * HEAD_DIM
ATTN_IN_W = 2 * Q_W + 2 * KV_W
WINDOW = 128
BLOCK = 128
ATTN_SCALE = HEAD_DIM ** -0.5
POOL_EXPAND = 2
POOL_W = POOL_EXPAND * D_MODEL
POOL_WINDOWS = (2, 4, 8, 16)
N_POOL_GROUPS = len(POOL_WINDOWS)
POOL_GW = POOL_W // N_POOL_GROUPS
PLE_DIM = 256
EPS = 1e-6

kernel_name = "hybrid_swa_pool_ple_encoder"


def rms_norm(x, g):
    xf = x.astype(jnp.float32)
    y = xf * lax.rsqrt(jnp.mean(xf * xf, axis=-1, keepdims=True) + EPS)
    return (y * g.astype(jnp.float32)).astype(x.dtype)


def alibi_slopes():
    return 2.0 ** (-8.0 * jnp.arange(1, N_HEADS + 1, dtype=jnp.float32) / N_HEADS)


def windowed_gqa(h, w_in, q_g, k_g, sink, w_out):
    B, S, _ = h.shape
    u = h @ w_in
    q, k, v, z = jnp.split(u, [Q_W, Q_W + KV_W, Q_W + 2 * KV_W], axis=-1)
    q = rms_norm(q.reshape(B, S, N_KV, GROUP, HEAD_DIM), q_g)
    k = rms_norm(k.reshape(B, S, N_KV, HEAD_DIM), k_g)
    v = v.reshape(B, S, N_KV, HEAD_DIM)
    nb = S // BLOCK
    pad = ((0, 0), (BLOCK, BLOCK), (0, 0), (0, 0))
    kp = jnp.pad(k, pad)
    vp = jnp.pad(v, pad)
    qb = q.reshape(B, nb, BLOCK, N_KV, GROUP, HEAD_DIM).transpose(1, 0, 2, 3, 4, 5)
    slopes = alibi_slopes().reshape(N_KV, GROUP)
    sink_f = sink.astype(jnp.float32).reshape(N_KV, GROUP)

    def band_block(args):
        qi, bi = args
        kw = lax.dynamic_slice_in_dim(kp, bi * BLOCK, 3 * BLOCK, axis=1)
        vw = lax.dynamic_slice_in_dim(vp, bi * BLOCK, 3 * BLOCK, axis=1)
        s = jnp.einsum('btkgd,bskd->bkgts', qi.astype(jnp.float32),
                       kw.astype(jnp.float32)) * ATTN_SCALE
        t_pos = bi * BLOCK + jnp.arange(BLOCK)
        s_pos = bi * BLOCK - BLOCK + jnp.arange(3 * BLOCK)
        dist = jnp.abs(t_pos[:, None] - s_pos[None, :])
        valid = (dist <= WINDOW) & (s_pos >= 0)[None, :] & (s_pos < S)[None, :]
        s = s - slopes[:, :, None, None] * dist.astype(jnp.float32)
        s = jnp.where(valid, s, -jnp.inf)
        sink_col = jnp.broadcast_to(sink_f[None, :, :, None, None], s.shape[:-1] + (1,))
        pr = jax.nn.softmax(jnp.concatenate([s, sink_col], axis=-1), axis=-1)[..., :-1]
        o = jnp.einsum('bkgts,bskd->btkgd', pr, vw.astype(jnp.float32))
        return o.astype(h.dtype)

    o = lax.map(band_block, (qb, jnp.arange(nb)))
    o = o.transpose(1, 0, 2, 3, 4, 5).reshape(B, S, Q_W)
    return (o * jax.nn.silu(z)) @ w_out


def multiscale_pool(h, w_in, w_grp, scale, w_out):
    B, S, _ = h.shape
    u = h @ w_in
    v, z = jnp.split(u, 2, axis=-1)
    vf = v.astype(jnp.float32)
    c = jnp.pad(jnp.cumsum(vf, axis=1), ((0, 0), (1, 0), (0, 0)))
    t = jnp.arange(S)
    outs = []
    for j, w in enumerate(POOL_WINDOWS):
        left = (w - 1) // 2
        right = w - 1 - left
        lo = jnp.clip(t - left, 0, S)
        hi = jnp.clip(t + right + 1, 0, S)
        cj = c[..., j * POOL_GW:(j + 1) * POOL_GW]
        win_sum = jnp.take(cj, hi, axis=1) - jnp.take(cj, lo, axis=1)
        mean = win_sum / (hi - lo).astype(jnp.float32)[None, :, None]
        outs.append(mean - vf[..., j * POOL_GW:(j + 1) * POOL_GW])
    d = jnp.stack(outs, axis=2).astype(h.dtype)
    y = jnp.einsum('bsgc,gcd->bsgd', d, w_grp).reshape(B, S, POOL_W) * scale
    return (y * jax.nn.silu(z)) @ w_out


def per_layer_embed(x, p_i, norm_g, w_gate, w_proj):
    gate = jax.nn.sigmoid((rms_norm(x, norm_g) @ w_gate).astype(jnp.float32))
    return x + (p_i @ w_proj) * gate.astype(x.dtype)


def setup_inputs(seed: int = 0) -> dict:
    key = jax.random.key(seed)
    ks = jax.random.split(key, 16)
    f32 = jnp.float32
    nrm = lambda k, shape, s: jax.random.normal(k, shape, f32) * s
    return {
        "x": nrm(ks[0], (BATCH, SEQ, D_MODEL), 1.0),
        "p": nrm(ks[1], (DEPTH, BATCH, SEQ, PLE_DIM), 1.0),
        "norm_g": 1.0 + nrm(ks[2], (DEPTH, D_MODEL), 0.02),
        "attn_w_in": nrm(ks[3], (N_ATTN_LAYERS, D_MODEL, ATTN_IN_W), D_MODEL ** -0.5),
        "attn_q_norm_g": 1.0 + nrm(ks[4], (N_ATTN_LAYERS, HEAD_DIM), 0.02),
        "attn_k_norm_g": 1.0 + nrm(ks[5], (N_ATTN_LAYERS, HEAD_DIM), 0.02),
        "attn_sink": nrm(ks[6], (N_ATTN_LAYERS, N_HEADS), 0.5),
        "attn_w_out": nrm(ks[7], (N_ATTN_LAYERS, Q_W, D_MODEL), Q_W ** -0.5),
        "pool_w_in": nrm(ks[8], (N_POOL_LAYERS, D_MODEL, 2 * POOL_W), D_MODEL ** -0.5),
        "pool_w_grp": nrm(ks[9], (N_POOL_LAYERS, N_POOL_GROUPS, POOL_GW, POOL_GW), POOL_GW ** -0.5),
        "pool_scale": 1.0 + nrm(ks[10], (N_POOL_LAYERS, POOL_W), 0.1),
        "pool_w_out": nrm(ks[11], (N_POOL_LAYERS, POOL_W, D_MODEL), POOL_W ** -0.5),
        "ple_norm_g": 1.0 + nrm(ks[12], (DEPTH, D_MODEL), 0.02),
        "ple_w_gate": nrm(ks[13], (DEPTH, D_MODEL, D_MODEL), D_MODEL ** -0.5),
        "ple_w_proj": nrm(ks[14], (DEPTH, PLE_DIM, D_MODEL), PLE_DIM ** -0.5),
    }


def reference(x, p, norm_g, attn_w_in, attn_q_norm_g, attn_k_norm_g, attn_sink,
              attn_w_out, pool_w_in, pool_w_grp, pool_scale, pool_w_out,
              ple_norm_g, ple_w_gate, ple_w_proj):
    for i in range(DEPTH):
        h = rms_norm(x, norm_g[i])
        j = i // N_MIXERS
        if i % N_MIXERS == 0:
            x = x + windowed_gqa(h, attn_w_in[j], attn_q_norm_g[j], attn_k_norm_g[j],
                                 attn_sink[j], attn_w_out[j])
        else:
            x = x + multiscale_pool(h, pool_w_in[j], pool_w_grp[j], pool_scale[j],
                                    pool_w_out[j])
        x = per_layer_embed(x, p[i], ple_norm_g[i], ple_w_gate[i], ple_w_proj[i])
    return x
```

```cpp
#include <hip/hip_runtime.h>
#include <cstdio>
#include <cstdint>

#define LAS __attribute__((address_space(3)))
#define GAS __attribute__((address_space(1)))
typedef unsigned short bf16;
typedef _Float16 bf16x8 __attribute__((ext_vector_type(8)));
typedef float f32x4 __attribute__((ext_vector_type(4)));
typedef float f32x2 __attribute__((ext_vector_type(2)));
typedef float f32x16 __attribute__((ext_vector_type(16)));
typedef unsigned u32x4 __attribute__((ext_vector_type(4)));
typedef unsigned u32x2 __attribute__((ext_vector_type(2)));
typedef GAS unsigned gu32;

#ifndef PROBE_PRO
#define PROBE_PRO 1
#endif
#ifndef PROBE_NORM
#define PROBE_NORM 1
#endif
#ifndef PROBE_ATT
#define PROBE_ATT 1
#endif
#ifndef PROBE_POOL
#define PROBE_POOL 1
#endif
#define REPEAT(n) _Pragma("nounroll") for (int _rep = 0, _n = launder_i(n); _rep < _n; ++_rep)
#ifndef FP8_GATE_MASK
#define FP8_GATE_MASK 0x0
#endif
#ifndef I8_GATE_MASK
#define I8_GATE_MASK 0xF
#endif
#ifndef I8_AIN_MASK
#define I8_AIN_MASK 0x3
#endif
#ifndef I8_PIN_MASK
#define I8_PIN_MASK 0x2
#endif
#ifndef I8_PINY_MASK
#define I8_PINY_MASK 0x1
#endif
#define I8_PANY (I8_PIN_MASK | I8_PINY_MASK)
static_assert((I8_PIN_MASK & I8_PINY_MASK) == 0 && (I8_PINY_MASK & ~I8_AIN_MASK) == 0, "I8_PINY needs the int8 attention slot's spare half");
#ifndef MK_ONE_LAUNCH
#define MK_ONE_LAUNCH 1
#endif

constexpr int S = 16384, D = 4096, DEPTH = 4;
constexpr int QW = 4096, KVW = 1024, AIN = 10240, NKV = 8, HD = 128;
constexpr int POOLW = 8192, GW = 2048, PLE = 256;
constexpr float EPS = 1e-6f;
constexpr float LOG2E = 1.4426950408889634f;

constexpr size_t MiB = 1u << 20;
constexpr size_t WS_CTL = 0, CTL_ZERO_BYTES = 4 * MiB;
constexpr size_t WS_WAIN = 6 * MiB;
constexpr size_t WS_WAOUT = WS_WAIN + 160 * MiB;
constexpr size_t WS_WPIN = WS_WAOUT + 64 * MiB;
constexpr size_t WS_WGRP = WS_WPIN + 256 * MiB;
constexpr size_t WS_WPOUT = WS_WGRP + 64 * MiB;
constexpr size_t WS_WGATE = WS_WPOUT + 128 * MiB;
constexpr size_t WS_WPROJ = WS_WGATE + 128 * MiB;
constexpr size_t WS_PBF = WS_WPROJ + 8 * MiB;
constexpr size_t WS_H = WS_PBF + 32 * MiB;
constexpr size_t WS_H1 = WS_H + 128 * MiB;
constexpr size_t WS_PP = WS_H1 + 128 * MiB;
constexpr size_t WS_ACT = WS_PP + 128 * MiB;
constexpr size_t WS_END = WS_ACT + 768 * MiB;
constexpr size_t WS_WINV = WS_ACT + 512 * MiB;
constexpr size_t ACT_XI8 = 704 * MiB;
constexpr size_t ACT_Q = 0, ACT_K = 128 * MiB, ACT_Z = 160 * MiB, ACT_VT = 288 * MiB, ACT_G = 320 * MiB;
constexpr size_t ACT_V = 0, ACT_PZ = 256 * MiB, ACT_DP = 512 * MiB;

constexpr int CW_BAR = 4096;
constexpr size_t CTL_CMAXP = 2048 * 1024;
constexpr size_t CTL_CMAXA = 1856 * 1024;
constexpr size_t CTL_CMAX = 1792 * 1024;
constexpr size_t CTL_RSS = 512 * 1024;

constexpr int RING_BYTES = 131072;
constexpr int LDS_BYTES = 147456;
constexpr int LDSCTL_OFF = LDS_BYTES - 1024, MISC_OFF = LDSCTL_OFF + 320;

typedef _Float16 half2v __attribute__((ext_vector_type(2)));
__device__ __forceinline__ unsigned cvt_pk_bf16(float lo, float hi) { return __builtin_bit_cast(unsigned, __builtin_convertvector((f32x2){lo, hi}, half2v)); }
__device__ __forceinline__ float bf_lo(unsigned w) { return (float)__builtin_bit_cast(_Float16, (unsigned short)(w & 0xffffu)); }
__device__ __forceinline__ float bf_hi(unsigned w) { return (float)__builtin_bit_cast(_Float16, (unsigned short)(w >> 16)); }
__device__ __forceinline__ float fast_exp2(float x) { return __builtin_amdgcn_exp2f(x); }
__device__ __forceinline__ float fast_rcp(float x) { return __builtin_amdgcn_rcpf(x); }
__device__ __forceinline__ float sigmoidf_(float a) { return fast_rcp(1.0f + fast_exp2(-a * LOG2E)); }
__device__ __forceinline__ float siluf_(float a) { return a * sigmoidf_(a); }
__device__ __forceinline__ int launder_i(int n) { asm volatile("" : "+s"(n)); return n; }
__device__ __forceinline__ float wave_sum(float v) {
#pragma unroll
    for (int o = 1; o < 64; o <<= 1) v += __shfl_xor(v, o);
    return v;
}

__device__ __forceinline__ int lane_id();
namespace pg8 {
typedef unsigned short bf16_t;
constexpr int BM = 256, BK = 64, HALF = 128, HTB = HALF * BK * 2, STAGE_BYTES = 8 * HTB, NXCD = 8, WGM = 8;
__host__ __device__ __forceinline__ int lds_byte(int r, int c) { const int st = (r >> 4) * 2 + (c >> 5), rr = r & 15, cc = c & 31, ob = rr * 64 + cc * 2; return st * 1024 + (ob ^ (((ob >> 9) & 1) << 5)); }
__host__ __device__ __forceinline__ void stage_rc(int b, int& R, int& C) { const int st = b / 1024, sb = b % 1024, swz = sb ^ (((sb >> 9) & 1) << 5); R = (st >> 1) * 16 + swz / 64; C = (st & 1) * 32 + (swz % 64) / 2; }
__host__ __device__ __forceinline__ int perm32(int rho) { const int n = rho >> 4, i = rho & 15; return 8 * (i >> 2) + 4 * n + (i & 3); }

typedef int i32x4v __attribute__((ext_vector_type(4)));
struct Unit { int pm, pn; };
typedef unsigned long long rss_t;
__device__ __forceinline__ float rstd_of(const rss_t* p) { const rss_t v = __hip_atomic_load((const GAS rss_t*)p, __ATOMIC_RELAXED, __HIP_MEMORY_SCOPE_AGENT); return 1.0f / sqrtf((float)v * (1.0f / 16777216.0f / 4096.0f) + 1e-6f); }
constexpr float I8_CLIP = 4.5f;
__device__ __forceinline__ float i8_row_step(const rss_t* p) { const rss_t v = __hip_atomic_load((const GAS rss_t*)p, __ATOMIC_RELAXED, __HIP_MEMORY_SCOPE_AGENT); return sqrtf((float)v * (1.0f / 16777216.0f / 4096.0f)) * (I8_CLIP / 127.0f) + 1e-20f; }
__device__ __forceinline__ unsigned q8(float x, float inv) { const float r = __builtin_amdgcn_fmed3f(__builtin_rintf(x * inv), -127.0f, 127.0f); return (unsigned)(int)r & 0xffu; }
__device__ __forceinline__ unsigned pack_i8x4(float a, float b, float c, float d, float inv) { return q8(a, inv) | (q8(b, inv) << 8) | (q8(c, inv) << 16) | (q8(d, inv) << 24); }
__device__ __forceinline__ rss_t rss_fix(float v) { return (rss_t)(v * 16777216.0f + 0.5f); }
__device__ __forceinline__ void rss_add(rss_t* p, float v) { (void)__hip_atomic_fetch_add((GAS rss_t*)p, rss_fix(v), __ATOMIC_RELAXED, __HIP_MEMORY_SCOPE_AGENT); }
struct Gemm { const bf16_t* A; const bf16_t* Bt; int lda, ldb, M, N, K, gshift, gcols, bshift, bstride; };

struct StaticOrder {
    int nM, nN, nwg, G, c;
    __host__ __device__ void init(int M, int N, int G_, int c_) { nM = M / BM; nN = N / BM; nwg = nM * nN; G = G_; c = c_; }
    __host__ __device__ bool next(int i, Unit& u) const {
        const long L = (long)i * G + c; if (L >= nwg) return false;
        int wgid = (int)L; { const int q = nwg / NXCD, r = nwg % NXCD, xcd = wgid % NXCD, off = wgid / NXCD; wgid = (xcd < r ? xcd * (q + 1) : r * (q + 1) + (xcd - r) * q) + off; }
        const int nig = WGM * nN, gid = wgid / nig, fm = gid * WGM, gsz = (nM - fm) < WGM ? (nM - fm) : WGM;
        u.pm = fm + ((wgid % nig) % gsz); u.pn = (wgid % nig) / gsz; return true;
    }
};

struct EpiSplit {
    static constexpr bool PERM = true;
    bf16_t* p0; bf16_t* p1; bf16_t* p2; int ld0, ld1, ld2, t1, t2, rshift, rstride;
    const rss_t* rss; int smode;
    unsigned* rowmax; int rmshift, rmstride;
    const unsigned* cmax; const rss_t* rssq;
    __device__ __forceinline__ void operator()(const f32x4 (&acc)[2][2][4][2], const Unit& u, int wr, int wc, int fr, int fq) const {
        bf16_t* base; int ldc, colt;
        if (u.pn < t1) { base = p0; ldc = ld0; colt = u.pn * BM; }
        else if (u.pn < t2) { base = p1; ldc = ld1; colt = (u.pn - t1) * BM; }
        else { base = p2; ldc = ld2; colt = (u.pn - t2) * BM; }
        base += (size_t)(u.pm >> rshift) * rstride;
        const int row0 = u.pm * BM + wr * 64 + fr, col0 = colt + wc * 32 + 8 * fq, gcol0 = u.pn * BM + wc * 32 + 8 * fq;
        f32x4 cs[2][2];
#pragma unroll
        for (int bj = 0; bj < 2; ++bj)
#pragma unroll
            for (int n = 0; n < 2; ++n) { cs[bj][n] = (f32x4){1.f, 1.f, 1.f, 1.f};
                if (smode == 2) {
#pragma unroll
                    for (int e = 0; e < 4; ++e) { const int c = gcol0 + bj * HALF + 4 * n + e; cs[bj][n][e] = rstd_of(rss + c) * (cmax ? i8_row_step(rssq + c) : 1.0f); } }
                else if (cmax) { const u32x4 cm = *(const GAS u32x4*)(cmax + gcol0 + bj * HALF + 4 * n); cs[bj][n] = (f32x4){__uint_as_float(cm.x), __uint_as_float(cm.y), __uint_as_float(cm.z), __uint_as_float(cm.w)} * (1.0f / 127.0f); } }
#pragma unroll
        for (int ai = 0; ai < 2; ++ai)
#pragma unroll
            for (int m = 0; m < 4; ++m) { const int row = row0 + ai * HALF + m * 16; bf16_t* rowp = base + (size_t)row * ldc + col0;
                float rs = 1.f, rmx = 0.f;
                if (smode == 1) rs = rstd_of(rss + row) * (cmax ? i8_row_step(rssq + row) : 1.0f);
                else if (cmax) rs = __uint_as_float(__hip_atomic_load((const GAS unsigned*)cmax + row, __ATOMIC_RELAXED, __HIP_MEMORY_SCOPE_AGENT)) * (1.0f / 127.0f);
#pragma unroll
                for (int bj = 0; bj < 2; ++bj) { f32x4 v0 = acc[ai][bj][m][0], v1 = acc[ai][bj][m][1];
                    if (cmax) { v0 = __builtin_convertvector(__builtin_bit_cast(i32x4v, v0), f32x4); v1 = __builtin_convertvector(__builtin_bit_cast(i32x4v, v1), f32x4); }
                    v0 = v0 * cs[bj][0] * rs; v1 = v1 * cs[bj][1] * rs;
                    u32x4 w; w.x = cvt_pk_bf16(v0[0], v0[1]); w.y = cvt_pk_bf16(v0[2], v0[3]); w.z = cvt_pk_bf16(v1[0], v1[1]); w.w = cvt_pk_bf16(v1[2], v1[3]);
                    *(GAS u32x4*)(rowp + bj * HALF) = w;
                    if (rowmax) { const float a = fmaxf(fmaxf(fmaxf(fabsf(bf_lo(w.x)), fabsf(bf_hi(w.x))), fmaxf(fabsf(bf_lo(w.y)), fabsf(bf_hi(w.y)))), fmaxf(fmaxf(fabsf(bf_lo(w.z)), fabsf(bf_hi(w.z))), fmaxf(fabsf(bf_lo(w.w)), fabsf(bf_hi(w.w))))); rmx = fmaxf(rmx, a); } }
                if (rowmax) { rmx = fmaxf(rmx, __shfl_xor(rmx, 16)); rmx = fmaxf(rmx, __shfl_xor(rmx, 32));
                    if (fq == 0) __hip_atomic_fetch_max((GAS unsigned*)rowmax + row + (size_t)(u.pm >> rmshift) * rmstride, __float_as_uint(rmx), __ATOMIC_RELAXED, __HIP_MEMORY_SCOPE_AGENT); } }
    }
};
struct EpiRes {
    static constexpr bool PERM = true;
    const bf16_t* base; bf16_t* xb; rss_t* rss; int ldc; unsigned char* xb8; int q8mode; const rss_t* rss0;
    __device__ __forceinline__ void operator()(const f32x4 (&acc)[2][2][4][2], const Unit& u, int wr, int wc, int fr, int fq) const {
        const int row0 = u.pm * BM + wr * 64 + fr, col0 = u.pn * BM + wc * 32 + 8 * fq;
#pragma unroll
        for (int ai = 0; ai < 2; ++ai) {
            u32x4 b[4][2];
#pragma unroll
            for (int m = 0; m < 4; ++m)
#pragma unroll
                for (int bj = 0; bj < 2; ++bj) b[m][bj] = *(const GAS u32x4*)(base + (size_t)(row0 + ai * HALF + m * 16) * ldc + col0 + bj * HALF);
#pragma unroll
            for (int m = 0; m < 4; ++m) { const int row = row0 + ai * HALF + m * 16; const size_t off = (size_t)row * ldc + col0;
                float ss = 0.f; const float qinv = (xb8 && q8mode == 2) ? 1.0f / i8_row_step(rss0 + row) : 0.f;
#pragma unroll
                for (int bj = 0; bj < 2; ++bj) { const f32x4 a0 = acc[ai][bj][m][0], a1 = acc[ai][bj][m][1]; const u32x4 q = b[m][bj];
                    u32x4 w; w.x = cvt_pk_bf16(bf_lo(q.x) + a0[0], bf_hi(q.x) + a0[1]); w.y = cvt_pk_bf16(bf_lo(q.y) + a0[2], bf_hi(q.y) + a0[3]);
                    w.z = cvt_pk_bf16(bf_lo(q.z) + a1[0], bf_hi(q.z) + a1[1]); w.w = cvt_pk_bf16(bf_lo(q.w) + a1[2], bf_hi(q.w) + a1[3]);
                    *(GAS u32x4*)(xb + off + bj * HALF) = w;
                    const float r0 = bf_lo(w.x), r1 = bf_hi(w.x), r2 = bf_lo(w.y), r3 = bf_hi(w.y), r4 = bf_lo(w.z), r5 = bf_hi(w.z), r6 = bf_lo(w.w), r7 = bf_hi(w.w);
                    ss += (r0 * r0 + r1 * r1) + (r2 * r2 + r3 * r3) + (r4 * r4 + r5 * r5) + (r6 * r6 + r7 * r7);
                    if (xb8 && q8mode == 2) { *(GAS u32x2*)(xb8 + off + bj * HALF) = (u32x2){pack_i8x4(r0, r1, r2, r3, qinv), pack_i8x4(r4, r5, r6, r7, qinv)}; }
                    else if (xb8) { unsigned p0 = 0u, p1 = 0u;
                        p0 = __builtin_amdgcn_cvt_pk_fp8_f32(r0 * 8.f, r1 * 8.f, p0, false); p0 = __builtin_amdgcn_cvt_pk_fp8_f32(r2 * 8.f, r3 * 8.f, p0, true);
                        p1 = __builtin_amdgcn_cvt_pk_fp8_f32(r4 * 8.f, r5 * 8.f, p1, false); p1 = __builtin_amdgcn_cvt_pk_fp8_f32(r6 * 8.f, r7 * 8.f, p1, true);
                        *(GAS u32x2*)(xb8 + off + bj * HALF) = (u32x2){p0, p1}; } }
                ss += __shfl_xor(ss, 16); ss += __shfl_xor(ss, 32);
                if (fq == 0) rss_add(rss + row, ss); }
            asm volatile("" ::: "memory"); }
    }
};
struct EpiGate {
    static constexpr bool PERM = true;
    const bf16_t* x; const bf16_t* pp; const rss_t* rss_in; bf16_t* xb; rss_t* rss; float* outf; int ldc; float lscale; const unsigned* cmax; const rss_t* rss0; unsigned char* xq8;
    __device__ __forceinline__ void operator()(const f32x4 (&acc)[2][2][4][2], const Unit& u, int wr, int wc, int fr, int fq) const {
        const int row0 = u.pm * BM + wr * 64 + fr, col0 = u.pn * BM + wc * 32 + 8 * fq;
        f32x4 cs[2][2];
#pragma unroll
        for (int bj = 0; bj < 2; ++bj)
#pragma unroll
            for (int n = 0; n < 2; ++n) { cs[bj][n] = (f32x4){1.f, 1.f, 1.f, 1.f};
                if (cmax) { const u32x4 cm = *(const GAS u32x4*)(cmax + col0 + bj * HALF + 4 * n); cs[bj][n] = (f32x4){__uint_as_float(cm.x), __uint_as_float(cm.y), __uint_as_float(cm.z), __uint_as_float(cm.w)} * (1.0f / 127.0f); } }
#pragma unroll
        for (int ai = 0; ai < 2; ++ai)
#pragma unroll
            for (int mh = 0; mh < 2; ++mh) {
                u32x4 b[2][2], q[2][2]; float rs[2];
#pragma unroll
                for (int ml = 0; ml < 2; ++ml) { const int row = row0 + ai * HALF + (2 * mh + ml) * 16; rs[ml] = rstd_of(rss_in + row) * (cmax ? i8_row_step(rss0 + row) : lscale);
#pragma unroll
                    for (int bj = 0; bj < 2; ++bj) { b[ml][bj] = *(const GAS u32x4*)(x + (size_t)row * ldc + col0 + bj * HALF); q[ml][bj] = *(const GAS u32x4*)(pp + (size_t)row * ldc + col0 + bj * HALF); } }
#pragma unroll
                for (int ml = 0; ml < 2; ++ml) { const int m = 2 * mh + ml, row = row0 + ai * HALF + m * 16; const size_t off = (size_t)row * ldc + col0;
                    float ss = 0.f; const float qinv = xq8 ? 1.0f / i8_row_step(rss_in + row) : 0.f;
#pragma unroll
                    for (int bj = 0; bj < 2; ++bj) { f32x4 a0 = acc[ai][bj][m][0], a1 = acc[ai][bj][m][1];
                        if (cmax) { a0 = __builtin_convertvector(__builtin_bit_cast(i32x4v, a0), f32x4) * cs[bj][0]; a1 = __builtin_convertvector(__builtin_bit_cast(i32x4v, a1), f32x4) * cs[bj][1]; }
                        a0 = a0 * rs[ml]; a1 = a1 * rs[ml]; const u32x4 xx = b[ml][bj], pq = q[ml][bj]; f32x4 v0, v1;
                        v0[0] = bf_lo(xx.x) + bf_lo(pq.x) * sigmoidf_(a0[0]); v0[1] = bf_hi(xx.x) + bf_hi(pq.x) * sigmoidf_(a0[1]);
                        v0[2] = bf_lo(xx.y) + bf_lo(pq.y) * sigmoidf_(a0[2]); v0[3] = bf_hi(xx.y) + bf_hi(pq.y) * sigmoidf_(a0[3]);
                        v1[0] = bf_lo(xx.z) + bf_lo(pq.z) * sigmoidf_(a1[0]); v1[1] = bf_hi(xx.z) + bf_hi(pq.z) * sigmoidf_(a1[1]);
                        v1[2] = bf_lo(xx.w) + bf_lo(pq.w) * sigmoidf_(a1[2]); v1[3] = bf_hi(xx.w) + bf_hi(pq.w) * sigmoidf_(a1[3]);
                        if (xb) {
                            u32x4 w; w.x = cvt_pk_bf16(v0[0], v0[1]); w.y = cvt_pk_bf16(v0[2], v0[3]); w.z = cvt_pk_bf16(v1[0], v1[1]); w.w = cvt_pk_bf16(v1[2], v1[3]);
                            *(GAS u32x4*)(xb + off + bj * HALF) = w;
                            const float r0 = bf_lo(w.x), r1 = bf_hi(w.x), r2 = bf_lo(w.y), r3 = bf_hi(w.y), r4 = bf_lo(w.z), r5 = bf_hi(w.z), r6 = bf_lo(w.w), r7 = bf_hi(w.w);
                            ss += (r0 * r0 + r1 * r1) + (r2 * r2 + r3 * r3) + (r4 * r4 + r5 * r5) + (r6 * r6 + r7 * r7);
                            if (xq8) *(GAS u32x2*)(xq8 + off + bj * HALF) = (u32x2){pack_i8x4(r0, r1, r2, r3, qinv), pack_i8x4(r4, r5, r6, r7, qinv)};
                        } else { *(GAS f32x4*)(outf + off + bj * HALF) = v0; *(GAS f32x4*)(outf + off + bj * HALF + 4) = v1; } }
                    if (xb) { ss += __shfl_xor(ss, 16); ss += __shfl_xor(ss, 32); if (fq == 0) rss_add(rss + row, ss); } }
                asm volatile("" ::: "memory"); }
    }
};
struct EpiGrp {
    static constexpr bool PERM = true;
    bf16_t* O; const bf16_t* z; const float* scale; int ldc;
    __device__ __forceinline__ void operator()(const f32x4 (&acc)[2][2][4][2], const Unit& u, int wr, int wc, int fr, int fq) const {
        const int row0 = u.pm * BM + wr * 64 + fr, col0 = u.pn * BM + wc * 32 + 8 * fq;
        f32x4 sc[2][2];
#pragma unroll
        for (int bj = 0; bj < 2; ++bj)
#pragma unroll
            for (int n = 0; n < 2; ++n) sc[bj][n] = *(const GAS f32x4*)(scale + col0 + bj * HALF + 4 * n);
#pragma unroll
        for (int ai = 0; ai < 2; ++ai)
#pragma unroll
            for (int m = 0; m < 4; ++m) { const size_t off = (size_t)(row0 + ai * HALF + m * 16) * ldc + col0;
                u32x4 zz[2];
#pragma unroll
                for (int bj = 0; bj < 2; ++bj) zz[bj] = *(const GAS u32x4*)(z + off + bj * HALF);
#pragma unroll
                for (int bj = 0; bj < 2; ++bj) { const f32x4 v0 = acc[ai][bj][m][0] * sc[bj][0], v1 = acc[ai][bj][m][1] * sc[bj][1]; const u32x4 zw = zz[bj];
                    u32x4 w;
                    w.x = cvt_pk_bf16(v0[0] * siluf_(bf_lo(zw.x)), v0[1] * siluf_(bf_hi(zw.x))); w.y = cvt_pk_bf16(v0[2] * siluf_(bf_lo(zw.y)), v0[3] * siluf_(bf_hi(zw.y)));
                    w.z = cvt_pk_bf16(v1[0] * siluf_(bf_lo(zw.z)), v1[1] * siluf_(bf_hi(zw.z))); w.w = cvt_pk_bf16(v1[2] * siluf_(bf_lo(zw.w)), v1[3] * siluf_(bf_hi(zw.w)));
                    *(GAS u32x4*)(O + off + bj * HALF) = w; }
                if (m & 1) asm volatile("" ::: "memory"); }
    }
};

typedef int i32x8 __attribute__((ext_vector_type(8)));
__device__ __forceinline__ i32x8 cat8(const bf16x8 a, const bf16x8 b) { const i32x4v x = __builtin_bit_cast(i32x4v, a), y = __builtin_bit_cast(i32x4v, b); return (i32x8){x[0], x[1], x[2], x[3], y[0], y[1], y[2], y[3]}; }
template <class Epi, bool ALIGN_EPI = true, int MODE = 0>
__device__ __forceinline__ void gemm_phase(LAS unsigned char* lds, const Gemm g, const StaticOrder& S, const Epi& E, const int tid_in) {
    constexpr bool FP8 = (MODE == 1), I8 = (MODE == 2);
    int tid = tid_in; asm volatile("" : "+v"(tid));
    const int wid = __builtin_amdgcn_readfirstlane(tid >> 6), lane = tid & 63, wr = wid >> 2, wc = wid & 3, fr = lane & 15, fq = lane >> 4;
    const int K = g.K, nt = K / BK;
    unsigned voffA[2], voffB[2];
#pragma unroll
    for (int i = 0; i < 2; ++i) { int R, C; stage_rc(tid * 16 + i * 8192, R, C); const int Rb = Epi::PERM ? ((R & ~31) + perm32(R & 31)) : R;
        voffA[i] = (unsigned)(R * g.lda + C) * 2u; voffB[i] = (unsigned)(Rb * g.ldb + C) * 2u; }
    const size_t kstep = (size_t)(BK * 2);
    const size_t hstepA = (size_t)HALF * g.lda * 2, hstepB = (size_t)HALF * g.ldb * 2;
    const size_t tstepA = 2 * hstepA, tstepB = 2 * hstepB;
    const unsigned ldsw = (unsigned)wid * 1024u;
    const int aoff = lds_byte(wr * 64 + fr, fq * 8), boff = lds_byte(wc * 32 + fr, fq * 8);
#define PG8_SA(b, h) (((b) * 2 + (h)) * HTB)
#define PG8_SB(b, h) ((4 + (b) * 2 + (h)) * HTB)
#define PG8_STAGE(bufoff, gbase, voff) do { _Pragma("unroll") for (int _i = 0; _i < 2; ++_i) \
        { if constexpr (FP8) __builtin_amdgcn_global_load_lds((const GAS unsigned*)((const GAS char*)(gbase) + (voff)[_i]), (LAS unsigned*)(lds + (bufoff) + ldsw + _i * 8192), 16, 0, 0);   \
          else __builtin_amdgcn_global_load_lds((const unsigned*)((const char*)(gbase) + (voff)[_i]), (LAS unsigned*)(lds + (bufoff) + ldsw + _i * 8192), 16, 0, 0); } } while (0)
#define PG8_LD8(p) __builtin_shufflevector(*(const LAS i32x4v*)(p), *(const LAS i32x4v*)((p) + 1024), 0, 1, 2, 3, 4, 5, 6, 7)
#define PG8_LDA(dst, b, h) do { if constexpr (FP8) { _Pragma("unroll") for (int m = 0; m < 4; ++m) dst##8[m] = PG8_LD8(lds + PG8_SA(b, h) + aoff + m * 2048); } else { _Pragma("unroll") for (int m = 0; m < 4; ++m) _Pragma("unroll") for (int k = 0; k < 2; ++k) dst[m][k] = *(const LAS bf16x8*)(lds + PG8_SA(b, h) + aoff + m * 2048 + k * 1024); } } while (0)
#define PG8_LDB(dst, b, h) do { if constexpr (FP8) { _Pragma("unroll") for (int n = 0; n < 2; ++n) dst##8[n] = PG8_LD8(lds + PG8_SB(b, h) + boff + n * 2048); } else { _Pragma("unroll") for (int n = 0; n < 2; ++n) _Pragma("unroll") for (int k = 0; k < 2; ++k) dst[n][k] = *(const LAS bf16x8*)(lds + PG8_SB(b, h) + boff + n * 2048 + k * 1024); } } while (0)
#define PG8_MMA(ai, bj, At, Bt) do { __builtin_amdgcn_s_setprio(0);   if constexpr (FP8) { _Pragma("unroll") for (int m = 0; m < 4; ++m) _Pragma("unroll") for (int n = 0; n < 2; ++n) \
        asm volatile("v_mfma_scale_f32_16x16x128_f8f6f4 %0, %1, %2, %0, %3, %3 op_sel_hi:[0,0,0]" : "+v"(acc[ai][bj][m][n]) : "v"(Bt##8[n]), "v"(At##8[m]), "v"(0x7F7F7F7F)); } else { \
        _Pragma("unroll") for (int m = 0; m < 4; ++m) _Pragma("unroll") for (int n = 0; n < 2; ++n) _Pragma("unroll") for (int k = 0; k < 2; ++k) { \
        if constexpr (I8) acc[ai][bj][m][n] = __builtin_bit_cast(f32x4, __builtin_amdgcn_mfma_i32_16x16x64_i8(__builtin_bit_cast(i32x4v, Bt[n][k]), __builtin_bit_cast(i32x4v, At[m][k]), __builtin_bit_cast(i32x4v, acc[ai][bj][m][n]), 0, 0, 0)); \
        else acc[ai][bj][m][n] = __builtin_amdgcn_mfma_f32_16x16x32_f16(Bt[n][k], At[m][k], acc[ai][bj][m][n], 0, 0, 0); } } __builtin_amdgcn_s_setprio(0); } while (0)
#define PG8_WAIT_V(n) asm volatile("s_waitcnt vmcnt(" #n ")" ::: "memory")
#define PG8_WAIT_L(n) asm volatile("s_waitcnt lgkmcnt(" #n ")" ::: "memory")
#define PG8_BAR __builtin_amdgcn_s_barrier()
#define PG8_SCHED __builtin_amdgcn_sched_barrier(0)
#define PG8_ABASE(u) ((const char*)g.A + (size_t)(u).pm * tstepA + (size_t)((u).pn >> g.gshift) * g.gcols * 2)
#define PG8_BBASE(u) ((const char*)g.Bt + (size_t)(u).pn * tstepB + (size_t)((u).pm >> g.bshift) * g.bstride * 2)
    Unit cur, nxt; int ui = 0;
    if (!S.next(0, cur)) return;
    f32x4 acc[2][2][4][2];
#pragma unroll
    for (int a = 0; a < 2; ++a)
#pragma unroll
        for (int b = 0; b < 2; ++b)
#pragma unroll
            for (int m = 0; m < 4; ++m)
#pragma unroll
                for (int n = 0; n < 2; ++n) acc[a][b][m][n] = (f32x4){0.f, 0.f, 0.f, 0.f};
    bf16x8 At[4][2], B0[2][2], B1[2][2]; i32x8 At8[4], B08[2], B18[2];
    const char* cA = PG8_ABASE(cur); const char* cB = PG8_BBASE(cur);
    PG8_STAGE(PG8_SB(0, 0), cB, voffB); PG8_STAGE(PG8_SB(0, 1), cB + hstepB, voffB); PG8_STAGE(PG8_SA(0, 0), cA, voffA); PG8_STAGE(PG8_SA(0, 1), cA + hstepA, voffA);
    if (wr == 1) PG8_BAR;
    PG8_WAIT_V(2); PG8_BAR;
    PG8_STAGE(PG8_SB(1, 0), cB + kstep, voffB); PG8_STAGE(PG8_SA(1, 0), cA + kstep, voffA); PG8_STAGE(PG8_SB(1, 1), cB + hstepB + kstep, voffB);
    PG8_WAIT_V(6); PG8_BAR;
    for (;;) {
        const bool has_next = S.next(ui + 1, nxt);
        const char* nA = has_next ? PG8_ABASE(nxt) : cA; const char* nB = has_next ? PG8_BBASE(nxt) : cB;
        const long kinc = (ui & 1) ? -(long)kstep : (long)kstep, nkinc = has_next ? -kinc : kinc;
        const char* sA = cA + ((ui & 1) ? (size_t)(nt - 1) * kstep : 0); const char* sB = cB + ((ui & 1) ? (size_t)(nt - 1) * kstep : 0);
        const char* nsA = has_next ? nA + ((ui & 1) ? 0 : (size_t)(nt - 1) * kstep) : sA; const char* nsB = has_next ? nB + ((ui & 1) ? 0 : (size_t)(nt - 1) * kstep) : sB;
        const char* pA = sA; const char* pB = sB;
        for (int t = 0; t < nt; t += 2, pA += 2 * kinc, pB += 2 * kinc) {
            const bool last = (t == nt - 2);
            const char* a1 = pA + kinc;
            const char* a2 = last ? nsA : pA + 2 * kinc; const char* b2 = last ? nsB : pB + 2 * kinc;
            const char* a3 = a2 + (last ? nkinc : kinc); const char* b3 = b2 + (last ? nkinc : kinc);
            PG8_LDB(B0, 0, 0); PG8_LDB(B1, 0, 1); PG8_SCHED; PG8_LDA(At, 0, 0); PG8_STAGE(PG8_SA(1, 1), a1 + hstepA, voffA);
            PG8_WAIT_V(8); PG8_WAIT_L(0); PG8_BAR; PG8_MMA(0, 0, At, B0); PG8_MMA(0, 1, At, B1); PG8_BAR; PG8_SCHED;
            PG8_LDA(At, 0, 1); PG8_STAGE(PG8_SB(0, 0), b2, voffB); PG8_STAGE(PG8_SB(0, 1), b2 + hstepB, voffB); PG8_STAGE(PG8_SA(0, 0), a2, voffA);
            PG8_WAIT_V(8); PG8_WAIT_L(0); PG8_BAR; PG8_MMA(1, 0, At, B0); PG8_MMA(1, 1, At, B1); PG8_BAR; PG8_SCHED;
            PG8_LDB(B0, 1, 0); PG8_LDB(B1, 1, 1); PG8_SCHED; PG8_LDA(At, 1, 0); PG8_STAGE(PG8_SA(0, 1), a2 + hstepA, voffA);
            PG8_WAIT_V(8); PG8_WAIT_L(0); PG8_BAR; PG8_MMA(0, 0, At, B0); PG8_MMA(0, 1, At, B1); PG8_BAR; PG8_SCHED;
            PG8_LDA(At, 1, 1); PG8_STAGE(PG8_SB(1, 0), b3, voffB); PG8_STAGE(PG8_SB(1, 1), b3 + hstepB, voffB); PG8_STAGE(PG8_SA(1, 0), a3, voffA);
            PG8_WAIT_V(8); PG8_WAIT_L(0); PG8_BAR; PG8_MMA(1, 0, At, B0); PG8_MMA(1, 1, At, B1); PG8_BAR; PG8_SCHED;
        }
        if constexpr (FP8) asm volatile("s_nop 15\n\ts_nop 15" ::: "memory");
        if constexpr (ALIGN_EPI) { if (wr == 0) PG8_BAR; }
        if constexpr (FP8) { const int le = lane_id(); E(acc, cur, wr, wc, le & 15, le >> 4); } else E(acc, cur, wr, wc, fr, fq);
        if (!has_next) break;
#pragma unroll
        for (int a = 0; a < 2; ++a)
#pragma unroll
            for (int b = 0; b < 2; ++b)
#pragma unroll
                for (int m = 0; m < 4; ++m)
#pragma unroll
                    for (int n = 0; n < 2; ++n) acc[a][b][m][n] = (f32x4){0.f, 0.f, 0.f, 0.f};
        cur = nxt; cA = nA; cB = nB; ++ui;
        if constexpr (ALIGN_EPI) { if (wr == 1) PG8_BAR; }
    }
    PG8_WAIT_V(0);
    if constexpr (!ALIGN_EPI) { if (wr == 0) PG8_BAR; }
    PG8_BAR;
#undef PG8_SA
#undef PG8_SB
#undef PG8_STAGE
#undef PG8_LDA
#undef PG8_LDB
#undef PG8_MMA
#undef PG8_WAIT_V
#undef PG8_WAIT_L
#undef PG8_BAR
#undef PG8_SCHED
#undef PG8_ABASE
#undef PG8_BBASE
}
}

#define XB_TMO      128
#define XB_XCNT(j)  (256  + 64 * (j))
#define XB_XSUB(j)  (1280 + 64 * (j))
#define XB_XGEN(j)  (2304 + 64 * (j))
#define XB_TOP      3328
#define XB_TOPGEN   3392
#define XCD_BAR_WORDS 3456
#define XB_SPIN_CAP (1u << 18)

__device__ __forceinline__ unsigned xb_ld(unsigned* p)              { return __hip_atomic_load(p, __ATOMIC_RELAXED, __HIP_MEMORY_SCOPE_AGENT); }
__device__ __forceinline__ unsigned xb_add(unsigned* p, unsigned v) { return __hip_atomic_fetch_add(p, v, __ATOMIC_RELAXED, __HIP_MEMORY_SCOPE_AGENT); }
__device__ __forceinline__ unsigned xb_xcc_id() { return (unsigned)__builtin_amdgcn_s_getreg((3 << 11) | 20) & 0xFu; }
#define XB_SPIN(cond, bar) do { unsigned _sp = 0; while (cond) { __builtin_amdgcn_s_sleep(1); \
    if ((++_sp & 255u) == 0u) { if (xb_ld(&(bar)[XB_TMO])) break; if (_sp > XB_SPIN_CAP) { atomicAdd(&(bar)[XB_TMO], 1u); break; } } } } while (0)

struct XcdBarrier {
    unsigned* bar; unsigned x;
    volatile LAS unsigned* st;
    int wave;
};
__device__ __forceinline__ int lane_id() { unsigned m = ~0u; asm volatile("" : "+s"(m)); return (int)__builtin_amdgcn_mbcnt_hi(m, __builtin_amdgcn_mbcnt_lo(m, 0u)); }
#define XB_T0(b) ((b).wave == 0 && lane_id() == 0)
__device__ __forceinline__ XcdBarrier xcd_barrier_post(unsigned* bar, volatile LAS unsigned* st, int wave) {
    XcdBarrier b; b.bar = bar; b.x = xb_xcc_id(); b.st = st; b.wave = wave;
    if (XB_T0(b)) (void)xb_add(&bar[XB_XCNT(b.x)], 1u);
    return b;
}
__device__ __forceinline__ void xcd_barrier_complete(unsigned* bar, unsigned x, unsigned& nloc, unsigned& nx) {
    const unsigned G = gridDim.x * gridDim.y * gridDim.z;
    unsigned sum, cnt, mine, sp = 0u;
    for (;;) {
        sum = 0u; cnt = 0u; mine = 0u;
#pragma unroll
        for (unsigned j = 0; j < 16; ++j) { const unsigned c = xb_ld(&bar[XB_XCNT(j)]); sum += c; cnt += (c > 0u) ? 1u : 0u; mine = (j == x) ? c : mine; }
        if (sum == G) break;
        __builtin_amdgcn_s_sleep(1);
        if ((++sp & 255u) == 0u) { if (xb_ld(&bar[XB_TMO])) break; if (sp > XB_SPIN_CAP) { atomicAdd(&bar[XB_TMO], 1u); break; } }
    }
    nloc = mine > 0u ? mine : 1u; nx = cnt > 0u ? cnt : 1u;
}
__device__ __forceinline__ void xcd_barrier(const XcdBarrier& b) {
    asm volatile("s_waitcnt vmcnt(0)" ::: "memory");
    __syncthreads();
    if (XB_T0(b)) {
        unsigned* bar = b.bar;
        __builtin_amdgcn_s_waitcnt(0);
        unsigned nloc = b.st[0], nx = b.st[1];
        if (nloc == 0u) { xcd_barrier_complete(bar, b.x, nloc, nx); b.st[0] = nloc; b.st[1] = nx; }
        const unsigned old = xb_add(&bar[XB_XSUB(b.x)], 1u);
        const unsigned gen = old / nloc;
        if (old + 1u == (gen + 1u) * nloc) {
            __builtin_amdgcn_fence(__ATOMIC_RELEASE, "agent");
            asm volatile("s_waitcnt vmcnt(0)" ::: "memory");
            const unsigned og = xb_add(&bar[XB_TOP], 1u);
            const unsigned tg = og / nx;
            if (og + 1u == (tg + 1u) * nx) xb_add(&bar[XB_TOPGEN], 1u);
            else XB_SPIN(xb_ld(&bar[XB_TOPGEN]) == tg, bar);
            __builtin_amdgcn_fence(__ATOMIC_ACQUIRE, "agent");
            xb_add(&bar[XB_XGEN(b.x)], 1u);
            asm volatile("s_waitcnt vmcnt(0)" ::: "memory");
        } else {
            XB_SPIN(xb_ld(&bar[XB_XGEN(b.x)]) == gen, bar);
            __builtin_amdgcn_fence(__ATOMIC_ACQUIRE, "agent");
            asm volatile("s_waitcnt vmcnt(0)" ::: "memory");
        }
    }
    __syncthreads();
}

__device__ __forceinline__ unsigned f2bf(float f) { unsigned u = __builtin_bit_cast(unsigned, f); return (u + 0x7fffu + ((u >> 16) & 1u)) >> 16; }
__device__ __forceinline__ unsigned pk2(float lo, float hi) { return f2bf(lo) | (f2bf(hi) << 16); }
__device__ __forceinline__ void transpose_batch(const float* W, int nbatch, int K, int N, bf16* WT, int remap, LAS float* scr, int gw, int NGW, int lane, int nb_lo = 0, int nb_cnt = -1, const float* gk = nullptr, int gstride = 0, unsigned f8mask = 0u, unsigned i8mask = 0u, const unsigned* cmax = nullptr) {
    const int nblk = nb_cnt < 0 ? N / 32 : nb_cnt, kblk = K / 64, per = nblk * kblk, total = per * nbatch;
    const int rr = lane >> 3, c4 = lane & 7;
    f32x4 cur[8], nxt[8]; float gc[8], gn[8];
#define TB_DECODE(it_, b_, k0_, nb_) const int b_ = (it_) / per, _r##b_ = (it_) - b_ * per, _kb##b_ = _r##b_ / nblk, nb_ = nb_lo + (_r##b_ - _kb##b_ * nblk), k0_ = 64 * _kb##b_
#define TB_LOAD(dst, gd, b_, k0_, nb_) do { const GAS char* _ub = (const GAS char*)W + ((size_t)(b_) * K * N + (size_t)(k0_) * N + 32 * (nb_)) * 4;     \
        int _rr = rr; asm volatile("" : "+v"(_rr)); const unsigned _vo = (unsigned)(_rr * N + 4 * c4) * 4u;     \
        _Pragma("unroll") for (int i = 0; i < 8; ++i) dst[i] = *(const GAS f32x4*)(_ub + (size_t)(8 * i) * N * 4 + _vo); \
        if (gk) { const GAS float* _g = (const GAS float*)gk + (size_t)(b_) * gstride + (k0_) + rr; _Pragma("unroll") for (int i = 0; i < 8; ++i) gd[i] = _g[8 * i]; } \
        else { _Pragma("unroll") for (int i = 0; i < 8; ++i) gd[i] = 1.0f; } } while (0)
    int it = gw;
    if (it < total) { TB_DECODE(it, b0, k00, nb0); TB_LOAD(cur, gc, b0, k00, nb0); }
    while (it < total) {
        const int itn = it + NGW;
        if (itn < total) { TB_DECODE(itn, b1, k01, nb1); TB_LOAD(nxt, gn, b1, k01, nb1); }
        TB_DECODE(it, b, k0, nb);
        int drow0 = 32 * nb;
        if (remap) { if (drow0 >= 6144) drow0 -= 1024; else if (drow0 >= 5120) drow0 += 4096; }
#pragma unroll
        for (int i = 0; i < 8; ++i) { LAS float* s = scr + (8 * i + rr) * 33 + 4 * c4; const f32x4 v = cur[i] * gc[i]; s[0] = v[0]; s[1] = v[1]; s[2] = v[2]; s[3] = v[3]; }
        asm volatile("s_waitcnt lgkmcnt(0)" ::: "memory");
        { const int c = lane & 7; bf16* wt = WT + (size_t)b * K * N;
          if ((i8mask >> b) & 1u) {
#pragma unroll
              for (int j = 0; j < 4; ++j) { const int n = (lane >> 3) + 8 * j; const LAS float* s = scr + (8 * c) * 33 + n;
                  const float cm = __uint_as_float(__hip_atomic_load((const GAS unsigned*)cmax + (size_t)b * N + drow0 + n, __ATOMIC_RELAXED, __HIP_MEMORY_SCOPE_AGENT)), inv = cm > 0.f ? 127.0f / cm : 0.f;
                  *(GAS u32x2*)((unsigned char*)wt + (size_t)(drow0 + n) * K + k0 + 8 * c) = (u32x2){pg8::pack_i8x4(s[0 * 33], s[1 * 33], s[2 * 33], s[3 * 33], inv), pg8::pack_i8x4(s[4 * 33], s[5 * 33], s[6 * 33], s[7 * 33], inv)}; }
          } else if ((f8mask >> b) & 1u) {
#pragma unroll
              for (int j = 0; j < 4; ++j) { const int n = (lane >> 3) + 8 * j; const LAS float* s = scr + (8 * c) * 33 + n; unsigned p0 = 0u, p1 = 0u;
                  p0 = __builtin_amdgcn_cvt_pk_fp8_f32(s[0 * 33] * 64.f, s[1 * 33] * 64.f, p0, false); p0 = __builtin_amdgcn_cvt_pk_fp8_f32(s[2 * 33] * 64.f, s[3 * 33] * 64.f, p0, true);
                  p1 = __builtin_amdgcn_cvt_pk_fp8_f32(s[4 * 33] * 64.f, s[5 * 33] * 64.f, p1, false); p1 = __builtin_amdgcn_cvt_pk_fp8_f32(s[6 * 33] * 64.f, s[7 * 33] * 64.f, p1, true);
                  *(GAS u32x2*)((unsigned char*)wt + (size_t)(drow0 + n) * K + k0 + 8 * c) = (u32x2){p0, p1}; }
          } else {
#pragma unroll
          for (int j = 0; j < 4; ++j) { const int n = (lane >> 3) + 8 * j; const LAS float* s = scr + (8 * c) * 33 + n;
              u32x4 o; o.x = cvt_pk_bf16(s[0 * 33], s[1 * 33]); o.y = cvt_pk_bf16(s[2 * 33], s[3 * 33]); o.z = cvt_pk_bf16(s[4 * 33], s[5 * 33]); o.w = cvt_pk_bf16(s[6 * 33], s[7 * 33]);
              *(GAS u32x4*)(wt + (size_t)(drow0 + n) * K + k0 + 8 * c) = o; } } }
        asm volatile("s_waitcnt lgkmcnt(0)" ::: "memory");
#pragma unroll
        for (int i = 0; i < 8; ++i) { cur[i] = nxt[i]; gc[i] = gn[i]; }
        it = itn;
    }
#undef TB_DECODE
#undef TB_LOAD
}
__device__ __forceinline__ void i8w_fused(const float* W, int nbat, unsigned bmask, int K, int ldw, int nb_lo, int nblk, int remap, const float* gk, int gstride, unsigned char* WTb, size_t wt_bstride, unsigned* cmax, int ostride, LAS unsigned char* lds, int vcu, int G, int tid_in, int task0 = 0) {
    int tid = tid_in; asm volatile("" : "+v"(tid));
    const int wave = __builtin_amdgcn_readfirstlane(tid >> 6), lane = tid & 63, rr = lane >> 3, c4 = lane & 7, kblk = K / 64;
    LAS float* scr = (LAS float*)(lds + wave * 16384); LAS float* cmw = (LAS float*)(lds + 131072); LAS float* cmf = cmw + 256;
    int first = vcu - (task0 % G); if (first < 0) first += G;
    for (int task = first; task < nbat * nblk; task += G) {
        const int b = task / nblk, nb = nb_lo + (task - b * nblk);
        if (!((bmask >> b) & 1u)) continue;
        int drow0 = 32 * nb;
        if (remap) { if (drow0 >= 6144) drow0 -= 1024; else if (drow0 >= 5120) drow0 += 4096; }
        const GAS char* ub = (const GAS char*)W + ((size_t)b * K * ldw + 32 * nb) * 4;
        const GAS float* gb = (const GAS float*)gk + (size_t)b * gstride;
#define I8F_LOAD(dst, gd, kb_) do { int _rr = rr; asm volatile("" : "+v"(_rr)); const unsigned _vo = (unsigned)(_rr * ldw + 4 * c4) * 4u; const GAS char* _ub = ub + (size_t)(kb_) * 64 * ldw * 4; \
        _Pragma("unroll") for (int i = 0; i < 8; ++i) dst[i] = *(const GAS f32x4*)(_ub + (size_t)(8 * i) * ldw * 4 + _vo); \
        _Pragma("unroll") for (int i = 0; i < 8; ++i) gd[i] = gb[(kb_) * 64 + 8 * i + _rr]; } while (0)
        f32x4 mx = (f32x4){0.f, 0.f, 0.f, 0.f};
        { f32x4 va[8], vb[8]; float ga[8], gbv[8];
#pragma nounroll
          for (int kb = wave; kb < kblk; kb += 16) {
              I8F_LOAD(va, ga, kb);
              const bool two = kb + 8 < kblk;
              if (two) I8F_LOAD(vb, gbv, kb + 8);
#pragma unroll
              for (int i = 0; i < 8; ++i) mx = __builtin_elementwise_max(mx, __builtin_elementwise_abs(va[i] * ga[i]));
              if (two) {
#pragma unroll
                  for (int i = 0; i < 8; ++i) mx = __builtin_elementwise_max(mx, __builtin_elementwise_abs(vb[i] * gbv[i])); } } }
#pragma unroll
        for (int sh = 8; sh < 64; sh <<= 1) {
#pragma unroll
            for (int e = 0; e < 4; ++e) mx[e] = fmaxf(mx[e], __shfl_xor(mx[e], sh)); }
        if (lane < 8) { LAS float* o = cmw + wave * 32 + 4 * c4; o[0] = mx[0]; o[1] = mx[1]; o[2] = mx[2]; o[3] = mx[3]; }
        __syncthreads();
        if (tid < 32) { float m = cmw[tid];
#pragma unroll
            for (int w = 1; w < 8; ++w) m = fmaxf(m, cmw[w * 32 + tid]);
            cmf[tid] = m; ((GAS unsigned*)cmax)[(size_t)b * ostride + drow0 + tid] = __float_as_uint(m); }
        __syncthreads();
        float inv[4];
#pragma unroll
        for (int j = 0; j < 4; ++j) { const float cm = cmf[rr + 8 * j]; inv[j] = cm > 0.f ? 127.0f / cm : 0.f; }
        { f32x4 cur[8], nxt[8]; float gc[8], gn[8];
          int kb = wave;
          if (kb < kblk) I8F_LOAD(cur, gc, kb);
#pragma nounroll
          while (kb < kblk) {
              const int kbn = kb + 8;
              if (kbn < kblk) I8F_LOAD(nxt, gn, kbn);
#pragma unroll
              for (int i = 0; i < 8; ++i) { LAS float* sp = scr + (8 * i + rr) * 33 + 4 * c4; const f32x4 v = cur[i] * gc[i]; sp[0] = v[0]; sp[1] = v[1]; sp[2] = v[2]; sp[3] = v[3]; }
              asm volatile("s_waitcnt lgkmcnt(0)" ::: "memory");
              unsigned char* wt = WTb + (size_t)b * wt_bstride;
#pragma unroll
              for (int j = 0; j < 4; ++j) { const int n = rr + 8 * j; const LAS float* sp = scr + (8 * c4) * 33 + n;
                  *(GAS u32x2*)(wt + (size_t)(drow0 + n) * K + 64 * kb + 8 * c4) = (u32x2){pg8::pack_i8x4(sp[0 * 33], sp[1 * 33], sp[2 * 33], sp[3 * 33], inv[j]), pg8::pack_i8x4(sp[4 * 33], sp[5 * 33], sp[6 * 33], sp[7 * 33], inv[j])}; }
              asm volatile("s_waitcnt lgkmcnt(0)" ::: "memory");
#pragma unroll
              for (int i = 0; i < 8; ++i) { cur[i] = nxt[i]; gc[i] = gn[i]; }
              kb = kbn; } }
#undef I8F_LOAD
    }
}
__device__ __forceinline__ void wq_rows(const bf16* src, unsigned char* dst, const unsigned* rowmax, int gw, int NGW, int lane) {
    for (int r = gw; r < POOLW; r += NGW) {
        const float cm = __uint_as_float(__hip_atomic_load((const GAS unsigned*)rowmax + r, __ATOMIC_RELAXED, __HIP_MEMORY_SCOPE_AGENT)), inv = cm > 0.f ? 127.0f / cm : 0.f;
        const GAS u32x4* s = (const GAS u32x4*)(src + (size_t)r * D) + lane; GAS u32x2* d = (GAS u32x2*)(dst + (size_t)r * D) + lane;
        u32x4 v[8];
#pragma unroll
        for (int i = 0; i < 8; ++i) v[i] = s[64 * i];
#pragma unroll
        for (int i = 0; i < 8; ++i) d[64 * i] = (u32x2){pg8::pack_i8x4(bf_lo(v[i].x), bf_hi(v[i].x), bf_lo(v[i].y), bf_hi(v[i].y), inv), pg8::pack_i8x4(bf_lo(v[i].z), bf_hi(v[i].z), bf_lo(v[i].w), bf_hi(v[i].w), inv)};
    }
}
__device__ __forceinline__ void xg_rows(const float* x, bf16* out, pg8::rss_t* rss, unsigned char* q8out, int gw, int NGW, int lane) {
    for (int m = gw; m < S; m += NGW) {
        const GAS f32x4* xr = (const GAS f32x4*)(x + (size_t)m * D) + lane;
        f32x4 v[16]; float s = 0.f;
        GAS u32x2* o8 = (GAS u32x2*)(out + (size_t)m * D) + lane;
#pragma unroll
        for (int j = 0; j < 16; ++j) v[j] = xr[64 * j];
#pragma unroll
        for (int j = 0; j < 16; ++j) { u32x2 w; w.x = cvt_pk_bf16(v[j][0], v[j][1]); w.y = cvt_pk_bf16(v[j][2], v[j][3]); o8[64 * j] = w;
            const float a0 = bf_lo(w.x), a1 = bf_hi(w.x), a2 = bf_lo(w.y), a3 = bf_hi(w.y); s += (a0 * a0 + a1 * a1) + (a2 * a2 + a3 * a3); }
        const float tot = wave_sum(s); const pg8::rss_t fx = pg8::rss_fix(tot); if (lane == 0) rss[m] = fx;
        if (q8out) {
            const float qinv = 1.0f / (sqrtf((float)fx * (1.0f / 16777216.0f / 4096.0f)) * (pg8::I8_CLIP / 127.0f) + 1e-20f);
            GAS unsigned* q = (GAS unsigned*)(q8out + (size_t)m * D) + lane;
#pragma unroll
            for (int j = 0; j < 16; ++j) { const unsigned w0 = cvt_pk_bf16(v[j][0], v[j][1]), w1 = cvt_pk_bf16(v[j][2], v[j][3]); q[64 * j] = pg8::pack_i8x4(bf_lo(w0), bf_hi(w0), bf_lo(w1), bf_hi(w1), qinv); } }
    }
}

__device__ __forceinline__ void acc8(float (&s)[8], const u32x4 q, const float w) {
    s[0] += w * bf_lo(q.x); s[1] += w * bf_hi(q.x); s[2] += w * bf_lo(q.y); s[3] += w * bf_hi(q.y); s[4] += w * bf_lo(q.z); s[5] += w * bf_hi(q.z); s[6] += w * bf_lo(q.w); s[7] += w * bf_hi(q.w);
}
__device__ __forceinline__ void poolgate_phase(const bf16* Y, const bf16* Z, const float* scale, bf16* G2, int vcu, int G, int tid) {
    constexpr int CH = 128;
    const int nunits = (S / CH) * 2;
    for (int u = vcu; u < nunits; u += G) {
        const int cb = u & 1, tc = u >> 1, t0 = tc * CH, c0 = cb * 4096 + tid * 8;
        const int j = c0 >> 11, w = 2 << j, left = (w - 1) >> 1, right = w - 1 - left;
        const bf16* yp = Y + c0; const bf16* zp = Z + c0; bf16* gp = G2 + c0;
        const f32x4 sc0 = *(const GAS f32x4*)(scale + c0), sc1 = *(const GAS f32x4*)(scale + c0 + 4);
        float sum[8];
#pragma unroll
        for (int e = 0; e < 8; ++e) sum[e] = 0.f;
        for (int s = t0 - left; s <= t0 + right; ++s) { const int sc = s < 0 ? 0 : (s >= S ? S - 1 : s); const float ws = (s >= 0 && s < S) ? 1.f : 0.f;
            acc8(sum, *(const GAS u32x4*)(yp + (size_t)sc * POOLW), ws); }
        for (int i0 = 0; i0 < CH; i0 += 8) {
            u32x4 cc[8], zz[8], qa[8], qd[8];
#pragma unroll
            for (int i = 0; i < 8; ++i) { const int t = t0 + i0 + i, sa = t + 1 + right, sd = t - left, sac = sa < S ? sa : S - 1, sdc = sd > 0 ? sd : 0;
                cc[i] = *(const GAS u32x4*)(yp + (size_t)t * POOLW); zz[i] = *(const GAS u32x4*)(zp + (size_t)t * POOLW);
                qa[i] = *(const GAS u32x4*)(yp + (size_t)sac * POOLW); qd[i] = *(const GAS u32x4*)(yp + (size_t)sdc * POOLW); }
#pragma unroll
            for (int i = 0; i < 8; ++i) { const int t = t0 + i0 + i, sa = t + 1 + right, sd = t - left;
                const int lo = (t - left) > 0 ? (t - left) : 0, hi = (t + right + 1) < S ? (t + right + 1) : S;
                const float inv = 1.0f / (float)(hi - lo);
                const u32x4 c = cc[i], z = zz[i];
                u32x4 o;
                o.x = cvt_pk_bf16((sum[0] * inv - bf_lo(c.x)) * sc0[0] * siluf_(bf_lo(z.x)), (sum[1] * inv - bf_hi(c.x)) * sc0[1] * siluf_(bf_hi(z.x)));
                o.y = cvt_pk_bf16((sum[2] * inv - bf_lo(c.y)) * sc0[2] * siluf_(bf_lo(z.y)), (sum[3] * inv - bf_hi(c.y)) * sc0[3] * siluf_(bf_hi(z.y)));
                o.z = cvt_pk_bf16((sum[4] * inv - bf_lo(c.z)) * sc1[0] * siluf_(bf_lo(z.z)), (sum[5] * inv - bf_hi(c.z)) * sc1[1] * siluf_(bf_hi(z.z)));
                o.w = cvt_pk_bf16((sum[6] * inv - bf_lo(c.w)) * sc1[2] * siluf_(bf_lo(z.w)), (sum[7] * inv - bf_hi(c.w)) * sc1[3] * siluf_(bf_hi(z.w)));
                *(GAS u32x4*)(gp + (size_t)t * POOLW) = o;
                acc8(sum, qa[i], sa < S ? 1.f : 0.f); acc8(sum, qd[i], sd >= 0 ? -1.f : 0.f); }
        }
    }
}

namespace att {
constexpr int KROW = 136, VROW = 68, OROW = 136;
constexpr int KT_BYTES = 64 * KROW * 2, VT_BYTES = 128 * VROW * 2, STAGE = KT_BYTES + VT_BYTES;
constexpr int O_OFF = 2 * STAGE, O_BYTES = 32 * OROW * 2;
constexpr int G_OFF = O_OFF + 8 * O_BYTES;
constexpr int ATT_LDS = G_OFF + 1024;
struct KV { u32x4 k0, k1, v0, v1; };
__device__ __forceinline__ void kv_load(KV& r, const bf16* Kg, const bf16* VT, int kvh, int s0, int tid) {
    asm volatile("" : "+v"(tid));
    const int key = tid >> 3, ch = tid & 7;
    const bf16* kp = Kg + (size_t)(s0 + key) * KVW + kvh * HD + ch * 16;
    r.k0 = *(const GAS u32x4*)kp; r.k1 = *(const GAS u32x4*)(kp + 8);
    r.v0 = *(const GAS u32x4*)(VT + (size_t)(kvh * HD + key) * S + s0 + ch * 8);
    r.v1 = *(const GAS u32x4*)(VT + (size_t)(kvh * HD + key + 64) * S + s0 + ch * 8);
}
__device__ __forceinline__ void kv_store(const KV& r, LAS unsigned char* stage, const LAS float* kgl, int tid) {
    asm volatile("" : "+v"(tid));
    const int key = tid >> 3, ch = tid & 7;
    LAS bf16* Kl = (LAS bf16*)stage; LAS bf16* Vl = (LAS bf16*)(stage + KT_BYTES);
    const u32x4 a = r.k0, b = r.k1;
    float v[16] = {bf_lo(a.x), bf_hi(a.x), bf_lo(a.y), bf_hi(a.y), bf_lo(a.z), bf_hi(a.z), bf_lo(a.w), bf_hi(a.w), bf_lo(b.x), bf_hi(b.x), bf_lo(b.y), bf_hi(b.y), bf_lo(b.z), bf_hi(b.z), bf_lo(b.w), bf_hi(b.w)};
    float ss = 0.f;
#pragma unroll
    for (int e = 0; e < 16; ++e) ss += v[e] * v[e];
    ss += __shfl_xor(ss, 1); ss += __shfl_xor(ss, 2); ss += __shfl_xor(ss, 4);
    const float rs = 1.0f / sqrtf(ss * (1.0f / HD) + EPS);
    const LAS f32x4* kg = (const LAS f32x4*)(kgl + ch * 16);
    const f32x4 g0 = kg[0], g1 = kg[1], g2 = kg[2], g3 = kg[3];
    u32x4 w0, w1;
    w0.x = cvt_pk_bf16(v[0] * rs * g0[0], v[1] * rs * g0[1]); w0.y = cvt_pk_bf16(v[2] * rs * g0[2], v[3] * rs * g0[3]); w0.z = cvt_pk_bf16(v[4] * rs * g1[0], v[5] * rs * g1[1]); w0.w = cvt_pk_bf16(v[6] * rs * g1[2], v[7] * rs * g1[3]);
    w1.x = cvt_pk_bf16(v[8] * rs * g2[0], v[9] * rs * g2[1]); w1.y = cvt_pk_bf16(v[10] * rs * g2[2], v[11] * rs * g2[3]); w1.z = cvt_pk_bf16(v[12] * rs * g3[0], v[13] * rs * g3[1]); w1.w = cvt_pk_bf16(v[14] * rs * g3[2], v[15] * rs * g3[3]);
    *(LAS u32x4*)(Kl + key * KROW + ch * 16) = w0; *(LAS u32x4*)(Kl + key * KROW + ch * 16 + 8) = w1;
    *(LAS u32x2*)(Vl + key * VROW + ch * 8) = (u32x2){r.v0.x, r.v0.y}; *(LAS u32x2*)(Vl + key * VROW + ch * 8 + 4) = (u32x2){r.v0.z, r.v0.w};
    *(LAS u32x2*)(Vl + (key + 64) * VROW + ch * 8) = (u32x2){r.v1.x, r.v1.y}; *(LAS u32x2*)(Vl + (key + 64) * VROW + ch * 8 + 4) = (u32x2){r.v1.z, r.v1.w};
}
__device__ __forceinline__ void unit_of(int u, int& kvh, int& qb) { kvh = (u >> 3) & 7; qb = ((u >> 6) << 3) + (u & 7); }
__device__ __forceinline__ void attn_phase(LAS unsigned char* lds, const bf16* Q, bf16* Gout, const bf16* Kg, const bf16* VT, const bf16* Z,
                                           const float* qgain, const float* kgain, const float* sink, int vcu, int G, int tid0) {
    int tid = tid0; const int wave = __builtin_amdgcn_readfirstlane(tid >> 6);
    int lane = tid & 63, lr = lane & 31, hh = lane >> 5;
    LAS float* gl = (LAS float*)(lds + G_OFF);
    LAS bf16* Ol = (LAS bf16*)(lds + O_OFF + wave * O_BYTES);
    if (tid < 128) gl[tid] = qgain[tid]; else if (tid < 256) gl[tid] = kgain[tid - 128];
    const int upw = (2048 + G - 1) / G;
    const int u_first = vcu * upw;
    u32x4 qraw[8]; KV kv;
    if (u_first < 2048) { int kvh, qb; unit_of(u_first, kvh, qb); const int t0 = qb * 64, c_lo = (2 - qb) > 0 ? (2 - qb) : 0;
        const bf16* qrow = Q + (size_t)(t0 + 32 * (wave & 1) + lr) * QW + (kvh * 4 + (wave >> 1)) * HD + 8 * hh;
#pragma unroll
        for (int j = 0; j < 8; ++j) qraw[j] = *(const GAS u32x4*)(qrow + 16 * j);
        kv_load(kv, Kg, VT, kvh, t0 - 128 + 64 * c_lo, tid); }
    __syncthreads();
    for (int ui = 0; ui < upw; ++ui) {
        const int u = u_first + ui; if (u >= 2048) break;
        asm volatile("" : "+v"(tid)); lane = tid & 63; lr = lane & 31; hh = lane >> 5;
        int kvh, qb; unit_of(u, kvh, qb);
        const int t0 = qb * 64, hq = kvh * 4 + (wave >> 1), tq = t0 + 32 * (wave & 1) + lr;
        const int c_lo = (2 - qb) > 0 ? (2 - qb) : 0, c_hi = (257 - qb) < 4 ? (257 - qb) : 4;
        const float slope2 = fast_exp2(-0.25f * (float)(hq + 1)) * LOG2E, sink2 = sink[hq] * LOG2E;
        bf16x8 qf[8];
        { float ss = 0.f;
#pragma unroll
          for (int j = 0; j < 8; ++j) { const float a0 = bf_lo(qraw[j].x), a1 = bf_hi(qraw[j].x), a2 = bf_lo(qraw[j].y), a3 = bf_hi(qraw[j].y), a4 = bf_lo(qraw[j].z), a5 = bf_hi(qraw[j].z), a6 = bf_lo(qraw[j].w), a7 = bf_hi(qraw[j].w);
              ss += (a0 * a0 + a1 * a1) + (a2 * a2 + a3 * a3) + (a4 * a4 + a5 * a5) + (a6 * a6 + a7 * a7); }
          ss += __shfl_xor(ss, 32);
          const float rs = (1.0f / sqrtf(ss * (1.0f / HD) + EPS)) * (0.08838834764831845f * LOG2E);
#pragma unroll
          for (int j = 0; j < 8; ++j) { const f32x4 g0 = *(const LAS f32x4*)(gl + 16 * j + 8 * hh), g1 = *(const LAS f32x4*)(gl + 16 * j + 8 * hh + 4);
              u32x4 w;
              w.x = cvt_pk_bf16(bf_lo(qraw[j].x) * rs * g0[0], bf_hi(qraw[j].x) * rs * g0[1]); w.y = cvt_pk_bf16(bf_lo(qraw[j].y) * rs * g0[2], bf_hi(qraw[j].y) * rs * g0[3]);
              w.z = cvt_pk_bf16(bf_lo(qraw[j].z) * rs * g1[0], bf_hi(qraw[j].z) * rs * g1[1]); w.w = cvt_pk_bf16(bf_lo(qraw[j].w) * rs * g1[2], bf_hi(qraw[j].w) * rs * g1[3]);
              qf[j] = __builtin_bit_cast(bf16x8, w); }
        }
        kv_store(kv, lds, gl + 128, tid);
        __syncthreads();
        float mrun = sink2, lrun = (hh == 0) ? 1.0f : 0.0f;
        f32x16 ot[4];
#pragma unroll
        for (int dt = 0; dt < 4; ++dt)
#pragma unroll
            for (int r = 0; r < 16; ++r) ot[dt][r] = 0.f;
        for (int c = c_lo; c <= c_hi; ++c) {
            const int s0 = t0 - 128 + 64 * c, st_i = (c - c_lo) & 1;
            asm volatile("" : "+v"(lr), "+v"(hh));
            if (c < c_hi) kv_load(kv, Kg, VT, kvh, s0 + 64, tid);
            const LAS bf16* Kl = (const LAS bf16*)(lds + st_i * STAGE); const LAS bf16* Vl = (const LAS bf16*)(lds + st_i * STAGE + KT_BYTES);
            f32x16 st[2];
#pragma unroll
            for (int kt = 0; kt < 2; ++kt) {
#pragma unroll
                for (int r = 0; r < 16; ++r) st[kt][r] = 0.f;
#pragma unroll
                for (int j = 0; j < 8; ++j) { const bf16x8 kf = *(const LAS bf16x8*)(Kl + (32 * kt + lr) * KROW + 16 * j + 8 * hh);
                    st[kt] = __builtin_amdgcn_mfma_f32_32x32x16_f16(kf, qf[j], st[kt], 0, 0, 0); } }
            const float fb = (float)(s0 + 4 * hh - tq);
            float mx = -INFINITY;
#pragma unroll
            for (int kt = 0; kt < 2; ++kt)
#pragma unroll
                for (int r = 0; r < 16; ++r) { const float ax = fabsf(fb + (float)(32 * kt + 8 * (r >> 2) + (r & 3)));
                    float v = st[kt][r] - slope2 * ax; v = (ax > 128.0f) ? -INFINITY : v; st[kt][r] = v; mx = fmaxf(mx, v); }
            mx = fmaxf(mx, __shfl_xor(mx, 32));
            const float mnew = fmaxf(mrun, mx), alpha = fast_exp2(mrun - mnew);
            mrun = mnew; lrun *= alpha;
#pragma unroll
            for (int dt = 0; dt < 4; ++dt)
#pragma unroll
                for (int r = 0; r < 16; ++r) ot[dt][r] *= alpha;
            bf16x8 pk[2][2];
#pragma unroll
            for (int kt = 0; kt < 2; ++kt)
#pragma unroll
                for (int jj = 0; jj < 2; ++jj) { float p[8];
#pragma unroll
                    for (int e = 0; e < 8; ++e) { p[e] = fast_exp2(st[kt][8 * jj + e] - mnew); lrun += p[e]; }
                    u32x4 w; w.x = cvt_pk_bf16(p[0], p[1]); w.y = cvt_pk_bf16(p[2], p[3]); w.z = cvt_pk_bf16(p[4], p[5]); w.w = cvt_pk_bf16(p[6], p[7]);
                    pk[kt][jj] = __builtin_bit_cast(bf16x8, w); }
#pragma unroll
            for (int kt = 0; kt < 2; ++kt)
#pragma unroll
                for (int jj = 0; jj < 2; ++jj)
#pragma unroll
                    for (int dt = 0; dt < 4; ++dt) { const LAS bf16* vp = Vl + (32 * dt + lr) * VROW + 32 * kt + 16 * jj + 4 * hh;
                        const u32x2 a0 = *(const LAS u32x2*)vp, a1 = *(const LAS u32x2*)(vp + 8);
                        const bf16x8 vf = __builtin_bit_cast(bf16x8, (u32x4){a0.x, a0.y, a1.x, a1.y});
                        ot[dt] = __builtin_amdgcn_mfma_f32_32x32x16_f16(vf, pk[kt][jj], ot[dt], 0, 0, 0); }
            if (c < c_hi) kv_store(kv, lds + (st_i ^ 1) * STAGE, gl + 128, tid);
            __syncthreads();
        }
        if (ui + 1 < upw && u + 1 < 2048) {
            int kvh2, qb2; unit_of(u + 1, kvh2, qb2); const int t02 = qb2 * 64, c_lo2 = (2 - qb2) > 0 ? (2 - qb2) : 0;
            const bf16* qrow = Q + (size_t)(t02 + 32 * (wave & 1) + lr) * QW + (kvh2 * 4 + (wave >> 1)) * HD + 8 * hh;
#pragma unroll
            for (int j = 0; j < 8; ++j) qraw[j] = *(const GAS u32x4*)(qrow + 16 * j);
            kv_load(kv, Kg, VT, kvh2, t02 - 128 + 64 * c_lo2, tid); }
        lrun += __shfl_xor(lrun, 32);
        const float inv = 1.0f / lrun;
#pragma unroll
        for (int dt = 0; dt < 4; ++dt)
#pragma unroll
            for (int g4 = 0; g4 < 4; ++g4) { u32x2 w; w.x = cvt_pk_bf16(ot[dt][4 * g4 + 0] * inv, ot[dt][4 * g4 + 1] * inv); w.y = cvt_pk_bf16(ot[dt][4 * g4 + 2] * inv, ot[dt][4 * g4 + 3] * inv);
                *(LAS u32x2*)(Ol + lr * OROW + 32 * dt + 8 * g4 + 4 * hh) = w; }
        asm volatile("s_waitcnt lgkmcnt(0)" ::: "memory");
        { const int rsub = lane >> 4, chunk = lane & 15; const size_t gbase = (size_t)(t0 + 32 * (wave & 1)) * QW + hq * HD + 8 * chunk;
          u32x4 zz[8];
#pragma unroll
          for (int i = 0; i < 8; ++i) zz[i] = *(const GAS u32x4*)(Z + gbase + (size_t)(4 * i + rsub) * QW);
#pragma unroll
          for (int i = 0; i < 8; ++i) { const u32x4 o = *(const LAS u32x4*)(Ol + (4 * i + rsub) * OROW + 8 * chunk); const u32x4 z = zz[i];
              u32x4 w;
              w.x = cvt_pk_bf16(bf_lo(o.x) * siluf_(bf_lo(z.x)), bf_hi(o.x) * siluf_(bf_hi(z.x))); w.y = cvt_pk_bf16(bf_lo(o.y) * siluf_(bf_lo(z.y)), bf_hi(o.y) * siluf_(bf_hi(z.y)));
              w.z = cvt_pk_bf16(bf_lo(o.z) * siluf_(bf_lo(z.z)), bf_hi(o.z) * siluf_(bf_hi(z.z))); w.w = cvt_pk_bf16(bf_lo(o.w) * siluf_(bf_lo(z.w)), bf_hi(o.w) * siluf_(bf_hi(z.w)));
              *(GAS u32x4*)(Gout + gbase + (size_t)(4 * i + rsub) * QW) = w; } }
    }
    __syncthreads();
}
}

struct Args { const float* in[15]; float* out; unsigned char* ws; int ph_lo, ph_hi; };
constexpr int N_PHASES = 1 + DEPTH * 7;

__global__ void __launch_bounds__(512, 2) fwd_kernel(Args args) {
    extern __shared__ __attribute__((aligned(16))) unsigned char lds_raw[];
    LAS unsigned char* lds = (LAS unsigned char*)lds_raw;
    volatile LAS unsigned* MISC = (volatile LAS unsigned*)(lds + MISC_OFF);
    const int tid = threadIdx.x, wave = __builtin_amdgcn_readfirstlane(tid >> 6);
    const int G = gridDim.x, bx = blockIdx.x;
    unsigned* ctl = (unsigned*)(args.ws + WS_CTL);
    for (int u = tid; u < (LDS_BYTES - LDSCTL_OFF) / 4; u += 512) ((LAS unsigned*)(lds + LDSCTL_OFF))[u] = 0u;
    __syncthreads();
    const int lo = args.ph_lo, hi = args.ph_hi;
    XcdBarrier bar; bar.bar = ctl + CW_BAR; bar.x = 0; bar.st = MISC + 8; bar.wave = wave;
    if (hi - lo > 1) bar = xcd_barrier_post(ctl + CW_BAR, MISC + 8, wave);
#define IN(k) (lo <= (k) && (k) < hi)
#define BOTH(k) (IN(k) && IN((k) + 1))
#define GRID_BAR(k) do { if (BOTH(k)) { XcdBarrier b2 = bar; LAUNDER_S(b2.bar); xcd_barrier(b2); } } while (0)

#define LAUNDER_S(x) asm volatile("" : "+s"(x))
#define LAUNDER_V(x) asm volatile("" : "+v"(x))
#define PHASE_BASES() unsigned char* wsp = args.ws; LAUNDER_S(wsp); int Gp = G, bxp = bx; LAUNDER_S(Gp); LAUNDER_S(bxp); int tidp = wave * 64 + lane_id(); LAUNDER_V(tidp); \
        const int lanep = tidp & 63, wavep = __builtin_amdgcn_readfirstlane(tidp >> 6); \
        const int vcu = (Gp % 8 == 0) ? (bxp % 8) * (Gp / 8) + bxp / 8 : bxp; const int gw = vcu * 8 + wavep, NGW = Gp * 8; (void)gw; (void)NGW; (void)wsp; (void)lanep

    if (IN(0)) {
        PHASE_BASES();
        LAS float* scr = (LAS float*)(lds + wavep * 16384);
        REPEAT(PROBE_PRO) {
        if ((I8_AIN_MASK & 0x3) != 0x3) {
#pragma nounroll
            for (int b = 0; b < 2; ++b) if (!((launder_i(I8_AIN_MASK) >> b) & 1))
                transpose_batch(args.in[3] + (size_t)b * D * AIN, 1, D, AIN, (bf16*)(wsp + WS_WAIN) + (size_t)b * D * AIN, 1, scr, gw, NGW, lanep, 0, -1, args.in[2] + (size_t)b * 2 * D, 2 * D); }
        transpose_batch(args.in[7], 2, QW, D, (bf16*)(wsp + WS_WAOUT), 0, scr, gw, NGW, lanep);
        if ((I8_PIN_MASK & 0x3) != 0x3) {
#pragma nounroll
            for (int b = 0; b < 2; ++b) if (!((launder_i(I8_PIN_MASK) >> b) & 1))
                transpose_batch(args.in[8] + (size_t)b * D * 2 * POOLW, 1, D, 2 * POOLW, (bf16*)(wsp + WS_WPIN) + (size_t)b * D * 2 * POOLW, 0, scr, gw, NGW, lanep, POOLW / 32, POOLW / 32, args.in[2] + D + (size_t)b * 2 * D, 2 * D); }
        {
          const GAS float* src = (const GAS float*)args.in[8]; bf16* dstb = (bf16*)(wsp + WS_WINV);
          for (int row = gw; row < 2 * D; row += NGW) { const int Lx = row / D, k = row - Lx * D;
              const float gg = args.in[2][(size_t)(2 * Lx + 1) * D + k]; const GAS f32x4* sp = (const GAS f32x4*)(src + (size_t)row * (2 * POOLW)) + lanep;
#pragma unroll
              for (int jj = 0; jj < 4; ++jj) { f32x4 v[8];
#pragma unroll
                  for (int i = 0; i < 8; ++i) v[i] = sp[(jj * 8 + i) * 64];
                  GAS u32x2* dp = (GAS u32x2*)(dstb + (((size_t)Lx * 4 + jj) * D + k) * GW) + lanep;
#pragma unroll
                  for (int i = 0; i < 8; ++i) { u32x2 w; w.x = cvt_pk_bf16(v[i][0] * gg, v[i][1] * gg); w.y = cvt_pk_bf16(v[i][2] * gg, v[i][3] * gg); dp[i * 64] = w; } } } }
        transpose_batch(args.in[9], 8, GW, GW, (bf16*)(wsp + WS_WGRP), 0, scr, gw, NGW, lanep);
        transpose_batch(args.in[11], 2, POOLW, D, (bf16*)(wsp + WS_WPOUT), 0, scr, gw, NGW, lanep);
        if ((I8_GATE_MASK & 0xF) != 0xF) {
#pragma nounroll
            for (int b = 0; b < 4; ++b) if (!((launder_i(I8_GATE_MASK) >> b) & 1))
                transpose_batch(args.in[13] + (size_t)b * D * D, 1, D, D, (bf16*)(wsp + WS_WGATE) + (size_t)b * D * D, 0, scr, gw, NGW, lanep, 0, -1, args.in[12] + (size_t)b * D, D, (FP8_GATE_MASK >> b) & 1u); }
        if (I8_GATE_MASK) { __syncthreads(); i8w_fused(args.in[13], 4, I8_GATE_MASK, D, D, 0, D / 32, 0, args.in[12], D, wsp + WS_WGATE, (size_t)D * D * 2, (unsigned*)(wsp + WS_CTL + CTL_CMAX), D, lds, vcu, Gp, tidp); }
        if (I8_AIN_MASK) { __syncthreads(); i8w_fused(args.in[3], 2, I8_AIN_MASK, D, AIN, 0, AIN / 32, 1, args.in[2], 2 * D, wsp + WS_WAIN, (size_t)D * AIN * 2, (unsigned*)(wsp + WS_CTL + CTL_CMAXA), AIN, lds, vcu, Gp, tidp, 128); }
        if (I8_PIN_MASK) { __syncthreads(); i8w_fused(args.in[8], 2, I8_PIN_MASK, D, 2 * POOLW, POOLW / 32, POOLW / 32, 0, args.in[2] + D, 2 * D, wsp + WS_WPIN, (size_t)D * 2 * POOLW * 2, (unsigned*)(wsp + WS_CTL + CTL_CMAXP), 2 * POOLW, lds, vcu, Gp, tidp); __syncthreads(); }
        transpose_batch(args.in[14], 4, PLE, D, (bf16*)(wsp + WS_WPROJ), 0, scr, gw, NGW, lanep);
        {
          constexpr int n4 = DEPTH * S * PLE / 4; const GAS f32x4* src = (const GAS f32x4*)args.in[1]; GAS u32x2* dst = (GAS u32x2*)(wsp + WS_PBF);
          for (int base = gw * 512; base < n4; base += NGW * 512) { f32x4 v[8];
#pragma unroll
              for (int i = 0; i < 8; ++i) v[i] = src[base + i * 64 + lanep];
#pragma unroll
              for (int i = 0; i < 8; ++i) { u32x2 w; w.x = cvt_pk_bf16(v[i][0], v[i][1]); w.y = cvt_pk_bf16(v[i][2], v[i][3]); dst[base + i * 64 + lanep] = w; } } }
        }
        GRID_BAR(0);
    }

    for (int L = 0; L < DEPTH; ++L) {
        const int pb = 1 + L * 7, jl = L >> 1; const bool is_attn = !(L & 1);
        if (IN(pb + 0) && L == 0) {
            PHASE_BASES();
            REPEAT(PROBE_NORM) xg_rows(args.in[0], (bf16*)(wsp + WS_H), (pg8::rss_t*)(wsp + WS_CTL + CTL_RSS), (I8_AIN_MASK & 1) ? (unsigned char*)(wsp + WS_ACT + ACT_XI8) : (unsigned char*)nullptr, gw, NGW, lanep);
            {
                constexpr int off0 = (I8_PIN_MASK & 1) ? POOLW : 0, off1 = (I8_PIN_MASK & 2) ? POOLW : 0;
                bf16* WP = (bf16*)(wsp + WS_WPIN) + (size_t)off0 * D;
                pg8::Gemm g2{(const bf16*)(wsp + WS_WGRP), (const bf16*)(wsp + WS_WINV), GW, GW, 2 * 4 * GW, D, GW, 0, 0, 3, D * GW};
                pg8::StaticOrder so2; so2.init(2 * 4 * GW, D, Gp, bxp);
                pg8::EpiSplit E2{WP, WP, WP, D, D, D, 1 << 30, 1 << 30, 5, (POOLW + off1 - off0) * D, nullptr, 0, I8_PANY ? (unsigned*)(wsp + WS_CTL + CTL_CMAXP) : (unsigned*)nullptr, 5, POOLW, nullptr, nullptr};
                pg8::gemm_phase<pg8::EpiSplit>(lds, g2, so2, E2, tidp);
            }
            GRID_BAR(pb + 0);
        }
        if (IN(pb + 1)) {
            PHASE_BASES();
            const bf16* H = (const bf16*)(wsp + WS_H); unsigned char* ACT = wsp + WS_ACT;
            const pg8::rss_t* rssA = (const pg8::rss_t*)(wsp + WS_CTL + CTL_RSS) + (size_t)(2 * L) * S;
            { bf16* PP = (bf16*)(wsp + WS_PP);
              pg8::Gemm g{(bf16*)(wsp + WS_PBF) + (size_t)L * S * PLE, (bf16*)(wsp + WS_WPROJ) + (size_t)L * D * PLE, PLE, PLE, S, D, PLE, 0, 0, 0, 0};
              pg8::StaticOrder so; so.init(S, D, Gp, bxp);
              pg8::EpiSplit E{PP, PP, PP, D, D, D, 1 << 30, 1 << 30, 0, 0, nullptr, 0, nullptr, 0, 0, nullptr, nullptr};
              pg8::gemm_phase<pg8::EpiSplit>(lds, g, so, E, tidp); }
            if (is_attn && I8_AIN_MASK != 0 && ((I8_AIN_MASK >> jl) & 1)) {
                const bf16* XI8 = (const bf16*)(ACT + ACT_XI8); const bf16* W8 = (const bf16*)(wsp + WS_WAIN) + (size_t)jl * AIN * D;
                const unsigned* cmx = (const unsigned*)(wsp + WS_CTL + CTL_CMAXA) + (size_t)jl * AIN;
                const pg8::rss_t* rssQ = (const pg8::rss_t*)(wsp + WS_CTL + CTL_RSS) + (size_t)(L == 0 ? 0 : 2 * L - 1) * S;
                { pg8::Gemm g{XI8, W8, D / 2, D / 2, S, 9216, D / 2, 0, 0, 0, 0}; pg8::StaticOrder so; so.init(S, 9216, Gp, bxp);
                  pg8::EpiSplit E{(bf16*)(ACT + ACT_Q), (bf16*)(ACT + ACT_K), (bf16*)(ACT + ACT_Z), QW, KVW, QW, 16, 20, 0, 0, rssA, 1, nullptr, 0, 0, cmx, rssQ};
                  pg8::gemm_phase<pg8::EpiSplit, true, 2>(lds, g, so, E, tidp); }
                { bf16* AVT = (bf16*)(ACT + ACT_VT);
                  pg8::Gemm g{W8 + (size_t)9216 * (D / 2), XI8, D / 2, D / 2, KVW, S, D / 2, 0, 0, 0, 0}; pg8::StaticOrder so; so.init(KVW, S, Gp, bxp);
                  pg8::EpiSplit E{AVT, AVT, AVT, S, S, S, 1 << 30, 1 << 30, 0, 0, rssA, 2, nullptr, 0, 0, cmx + 9216, rssQ};
                  pg8::gemm_phase<pg8::EpiSplit, true, 2>(lds, g, so, E, tidp); }
            } else if (is_attn) {
                const bf16* W = (const bf16*)(wsp + WS_WAIN) + (size_t)jl * AIN * D;
                { pg8::Gemm g{H, W, D, D, S, 9216, D, 0, 0, 0, 0}; pg8::StaticOrder so; so.init(S, 9216, Gp, bxp);
                  pg8::EpiSplit E{(bf16*)(ACT + ACT_Q), (bf16*)(ACT + ACT_K), (bf16*)(ACT + ACT_Z), QW, KVW, QW, 16, 20, 0, 0, rssA, 1, nullptr, 0, 0, nullptr, nullptr};
                  pg8::gemm_phase<pg8::EpiSplit>(lds, g, so, E, tidp); }
                { bf16* AVT = (bf16*)(ACT + ACT_VT);
                  pg8::Gemm g{W + (size_t)9216 * D, H, D, D, KVW, S, D, 0, 0, 0, 0}; pg8::StaticOrder so; so.init(KVW, S, Gp, bxp);
                  pg8::EpiSplit E{AVT, AVT, AVT, S, S, S, 1 << 30, 1 << 30, 0, 0, rssA, 2, nullptr, 0, 0, nullptr, nullptr};
                  pg8::gemm_phase<pg8::EpiSplit>(lds, g, so, E, tidp); }
            } else if (I8_PINY_MASK != 0 && ((I8_PINY_MASK >> jl) & 1)) {
                bf16* PZ = (bf16*)(ACT + ACT_PZ);
                { const bf16* XI8 = (const bf16*)(ACT + ACT_XI8); const bf16* W8 = (const bf16*)(wsp + WS_WAIN + (size_t)jl * D * AIN * 2 + (size_t)D * AIN);
                  const unsigned* cmx = (const unsigned*)(wsp + WS_CTL + CTL_CMAXP) + (size_t)jl * 2 * POOLW;
                  const pg8::rss_t* rssQ = (const pg8::rss_t*)(wsp + WS_CTL + CTL_RSS) + (size_t)(2 * L - 1) * S;
                  pg8::Gemm g{XI8, W8, D / 2, D / 2, S, POOLW, D / 2, 0, 0, 0, 0}; pg8::StaticOrder so; so.init(S, POOLW, Gp, bxp);
                  pg8::EpiSplit E{(bf16*)(ACT + ACT_V), PZ, PZ, POOLW, POOLW, POOLW, 1 << 30, 1 << 30, 0, 0, rssA, 1, nullptr, 0, 0, cmx, rssQ};
                  pg8::gemm_phase<pg8::EpiSplit, true, 2>(lds, g, so, E, tidp); }
                { const bf16* Wz = (const bf16*)(wsp + WS_WPIN) + (size_t)jl * 2 * POOLW * D + (size_t)POOLW * D;
                  pg8::Gemm g{H, Wz, D, D, S, POOLW, D, 0, 0, 0, 0}; pg8::StaticOrder so; so.init(S, POOLW, Gp, bxp);
                  pg8::EpiSplit E{PZ, PZ, PZ, POOLW, POOLW, POOLW, 1 << 30, 1 << 30, 0, 0, rssA, 1, nullptr, 0, 0, nullptr, nullptr};
                  pg8::gemm_phase<pg8::EpiSplit>(lds, g, so, E, tidp); }
            } else if (I8_PIN_MASK != 0 && ((I8_PIN_MASK >> jl) & 1)) {
                bf16* PZ = (bf16*)(ACT + ACT_PZ);
                const bf16* XI8 = (const bf16*)(ACT + ACT_XI8); const bf16* W8 = (const bf16*)(wsp + WS_WPIN) + (size_t)jl * 2 * POOLW * D;
                const unsigned* cmx = (const unsigned*)(wsp + WS_CTL + CTL_CMAXP) + (size_t)jl * 2 * POOLW;
                const pg8::rss_t* rssQ = (const pg8::rss_t*)(wsp + WS_CTL + CTL_RSS) + (size_t)(2 * L - 1) * S;
                pg8::Gemm g{XI8, W8, D / 2, D / 2, S, 2 * POOLW, D / 2, 0, 0, 0, 0}; pg8::StaticOrder so; so.init(S, 2 * POOLW, Gp, bxp);
                pg8::EpiSplit E{(bf16*)(ACT + ACT_V), PZ, PZ, POOLW, POOLW, POOLW, 32, 1 << 30, 0, 0, rssA, 1, nullptr, 0, 0, cmx, rssQ};
                pg8::gemm_phase<pg8::EpiSplit, true, 2>(lds, g, so, E, tidp);
            } else {
                bf16* PZ = (bf16*)(ACT + ACT_PZ);
                pg8::Gemm g{H, (const bf16*)(wsp + WS_WPIN) + (size_t)jl * 2 * POOLW * D, D, D, S, 2 * POOLW, D, 0, 0, 0, 0}; pg8::StaticOrder so; so.init(S, 2 * POOLW, Gp, bxp);
                pg8::EpiSplit E{(bf16*)(ACT + ACT_V), PZ, PZ, POOLW, POOLW, POOLW, 32, 1 << 30, 0, 0, rssA, 1, nullptr, 0, 0, nullptr, nullptr};
                pg8::gemm_phase<pg8::EpiSplit>(lds, g, so, E, tidp);
            }
            GRID_BAR(pb + 1);
        }
        if (IN(pb + 2)) {
            PHASE_BASES();
            unsigned char* ACT = wsp + WS_ACT;
            if (is_attn) REPEAT(PROBE_ATT) att::attn_phase(lds, (const bf16*)(ACT + ACT_Q), (bf16*)(ACT + ACT_G), (const bf16*)(ACT + ACT_K), (const bf16*)(ACT + ACT_VT), (const bf16*)(ACT + ACT_Z),
                                         args.in[4] + jl * HD, args.in[5] + jl * HD, args.in[6] + jl * 32, vcu, Gp, tidp);
            if (L == 0 && I8_PANY) {
#pragma nounroll
                for (int b = 0; b < 2; ++b) if ((launder_i(I8_PANY) >> b) & 1) { unsigned char* slot = wsp + WS_WPIN + (size_t)b * 2 * POOLW * D * 2; const bool yonly = (launder_i(I8_PINY_MASK) >> b) & 1;
                    wq_rows((const bf16*)(slot + (yonly ? (size_t)0 : (size_t)POOLW * D * 2)), yonly ? wsp + WS_WAIN + (size_t)b * D * AIN * 2 + (size_t)D * AIN : slot, (const unsigned*)(wsp + WS_CTL + CTL_CMAXP) + (size_t)b * 2 * POOLW, gw, NGW, lanep); } }
            if (!is_attn) REPEAT(PROBE_POOL) poolgate_phase((const bf16*)(ACT + ACT_V), (const bf16*)(ACT + ACT_PZ), args.in[10] + (size_t)jl * POOLW, (bf16*)(ACT + ACT_DP), vcu, Gp, tidp);
            GRID_BAR(pb + 2);
        }
        if (IN(pb + 4)) {
            PHASE_BASES();
            unsigned char* ACT = wsp + WS_ACT;
            const int Kc = is_attn ? QW : POOLW;
            pg8::Gemm g{is_attn ? (const bf16*)(ACT + ACT_G) : (const bf16*)(ACT + ACT_DP), is_attn ? (const bf16*)(wsp + WS_WAOUT) + (size_t)jl * D * QW : (const bf16*)(wsp + WS_WPOUT) + (size_t)jl * D * POOLW, Kc, Kc, S, D, Kc, 0, 0, 0, 0};
            pg8::StaticOrder so; so.init(S, D, Gp, bxp);
            pg8::EpiRes E{(const bf16*)(wsp + WS_H), (bf16*)(wsp + WS_H1), (pg8::rss_t*)(wsp + WS_CTL + CTL_RSS) + (size_t)(2 * L + 1) * S, D, (((FP8_GATE_MASK | I8_GATE_MASK) >> L) & 1) ? (unsigned char*)ACT : (unsigned char*)nullptr, ((I8_GATE_MASK >> L) & 1) ? 2 : 1,
                          (const pg8::rss_t*)(wsp + WS_CTL + CTL_RSS) + (size_t)(2 * L) * S};
            pg8::gemm_phase<pg8::EpiRes>(lds, g, so, E, tidp);
            GRID_BAR(pb + 4);
        }
        if (IN(pb + 6)) {
            PHASE_BASES();
            pg8::StaticOrder so; so.init(S, D, Gp, bxp);
            const bool more = (L + 1 < DEPTH); const bool i8 = ((I8_GATE_MASK >> L) & 1) != 0; const bool f8 = !i8 && ((FP8_GATE_MASK >> L) & 1) != 0;
            pg8::EpiGate E{(const bf16*)(wsp + WS_H1), (const bf16*)(wsp + WS_PP), (const pg8::rss_t*)(wsp + WS_CTL + CTL_RSS) + (size_t)(2 * L + 1) * S,
                           more ? (bf16*)(wsp + WS_H) : (bf16*)nullptr, (pg8::rss_t*)(wsp + WS_CTL + CTL_RSS) + (size_t)(more ? 2 * L + 2 : 0) * S, args.out, D, f8 ? (1.0f / 512.0f) : 1.0f,
                           i8 ? (const unsigned*)(wsp + WS_CTL + CTL_CMAX) + (size_t)L * D : (const unsigned*)nullptr, (const pg8::rss_t*)(wsp + WS_CTL + CTL_RSS) + (size_t)(2 * L) * S,
                           (more && (((L & 1) && ((I8_AIN_MASK >> ((L + 1) >> 1)) & 1)) || (!(L & 1) && ((I8_PANY >> (L >> 1)) & 1)))) ? (unsigned char*)(wsp + WS_ACT + ACT_XI8) : (unsigned char*)nullptr};
            if (I8_GATE_MASK != 0 && i8) {
                pg8::Gemm g{(const bf16*)(wsp + WS_ACT), (const bf16*)(wsp + WS_WGATE) + (size_t)L * D * D, D / 2, D / 2, S, D, D / 2, 0, 0, 0, 0};
                pg8::gemm_phase<pg8::EpiGate, true, 2>(lds, g, so, E, tidp);
            }
            if (FP8_GATE_MASK != 0 && f8) {
                pg8::Gemm g{(const bf16*)(wsp + WS_ACT), (const bf16*)(wsp + WS_WGATE) + (size_t)L * D * D, D / 2, D / 2, S, D, D / 2, 0, 0, 0, 0};
                pg8::gemm_phase<pg8::EpiGate, true, 1>(lds, g, so, E, tidp);
            }
            if (((FP8_GATE_MASK | I8_GATE_MASK) & 0xF) != 0xF && !f8 && !i8) {
                pg8::Gemm g{(const bf16*)(wsp + WS_H1), (const bf16*)(wsp + WS_WGATE) + (size_t)L * D * D, D, D, S, D, D, 0, 0, 0, 0};
                pg8::gemm_phase<pg8::EpiGate>(lds, g, so, E, tidp);
            }
            GRID_BAR(pb + 6);
        }
    }
#undef IN
#undef BOTH
#undef GRID_BAR
}

extern "C" void kernel_launch(void* const* d_in, const int* in_sizes, int n_in, void* d_out, int out_size, void* d_ws, size_t ws_size, hipStream_t stream) {
    static int grid = 0;
    if (grid == 0) {
        if (n_in != 15 || in_sizes[0] != S * D || out_size != S * D || ws_size < WS_END) {
            fprintf(stderr, "kernel_launch: unexpected shapes / workspace (n_in %d, in0 %d, out %d, ws %zu, need %zu); nothing launched\n", n_in, n_in > 0 ? in_sizes[0] : -1, out_size, ws_size, (size_t)WS_END); grid = -1; return; }
        int dev = 0, cus = 0, per_cu = 0;
        if (hipGetDevice(&dev) != hipSuccess || hipDeviceGetAttribute(&cus, hipDeviceAttributeMultiprocessorCount, dev) != hipSuccess) { grid = -1; return; }
        if (hipFuncSetAttribute((const void*)fwd_kernel, hipFuncAttributeMaxDynamicSharedMemorySize, LDS_BYTES) != hipSuccess) { fprintf(stderr, "kernel_launch: hipFuncSetAttribute failed\n"); grid = -1; return; }
        if (hipOccupancyMaxActiveBlocksPerMultiprocessor(&per_cu, (const void*)fwd_kernel, 512, LDS_BYTES) != hipSuccess || per_cu < 1)
            fprintf(stderr, "kernel_launch: note: occupancy query reports %d workgroups per CU\n", per_cu);
        (void)hipGetLastError();
        grid = cus;
    }
    if (grid < 0) return;
    if (hipMemsetAsync((char*)d_ws + WS_CTL, 0, CTL_ZERO_BYTES, stream) != hipSuccess) return;
    Args a{};
    for (int i = 0; i < 15; ++i) a.in[i] = (const float*)d_in[i];
    a.out = (float*)d_out; a.ws = (unsigned char*)d_ws;
#if MK_ONE_LAUNCH
    a.ph_lo = 0; a.ph_hi = N_PHASES;
    hipLaunchKernelGGL(fwd_kernel, dim3(grid), dim3(512), LDS_BYTES, stream, a);
#else
    for (int k = 0; k < N_PHASES; ++k) { a.ph_lo = k; a.ph_hi = k + 1; hipLaunchKernelGGL(fwd_kernel, dim3(grid), dim3(512), LDS_BYTES, stream, a); }
#endif
}
```

```cpp
#include <hip/hip_runtime.h>
#include <cstdio>
#include <cstdint>

#define LAS __attribute__((address_space(3)))
#define GAS __attribute__((address_space(1)))
typedef unsigned short bf16;
typedef _Float16 bf16x8 __attribute__((ext_vector_type(8)));
typedef float f32x4 __attribute__((ext_vector_type(4)));
typedef float f32x2 __attribute__((ext_vector_type(2)));
typedef float f32x16 __attribute__((ext_vector_type(16)));
typedef unsigned u32x4 __attribute__((ext_vector_type(4)));
typedef unsigned u32x2 __attribute__((ext_vector_type(2)));
typedef GAS unsigned gu32;

#ifndef PROBE_PRO
#define PROBE_PRO 1
#endif
#ifndef PROBE_NORM
#define PROBE_NORM 1
#endif
#ifndef PROBE_ATT
#define PROBE_ATT 1
#endif
#ifndef PROBE_POOL
#define PROBE_POOL 1
#endif
#define REPEAT(n) _Pragma("nounroll") for (int _rep = 0, _n = launder_i(n); _rep < _n; ++_rep)
#ifndef FP8_GATE_MASK
#define FP8_GATE_MASK 0x0
#endif
#ifndef I8_GATE_MASK
#define I8_GATE_MASK 0xF
#endif
#ifndef I8_AIN_MASK
#define I8_AIN_MASK 0x3
#endif
#ifndef I8_PIN_MASK
#define I8_PIN_MASK 0x2
#endif
#ifndef I8_PINY_MASK
#define I8_PINY_MASK 0x1
#endif
#define I8_PANY (I8_PIN_MASK | I8_PINY_MASK)
static_assert((I8_PIN_MASK & I8_PINY_MASK) == 0 && (I8_PINY_MASK & ~I8_AIN_MASK) == 0, "I8_PINY needs the int8 attention slot's spare half");
#ifndef MK_ONE_LAUNCH
#define MK_ONE_LAUNCH 1
#endif

constexpr int S = 16384, D = 4096, DEPTH = 4;
constexpr int QW = 4096, KVW = 1024, AIN = 10240, NKV = 8, HD = 128;
constexpr int POOLW = 8192, GW = 2048, PLE = 256;
constexpr float EPS = 1e-6f;
constexpr float LOG2E = 1.4426950408889634f;

constexpr size_t MiB = 1u << 20;
constexpr size_t WS_CTL = 0, CTL_ZERO_BYTES = 4 * MiB;
constexpr size_t WS_WAIN = 6 * MiB;
constexpr size_t WS_WAOUT = WS_WAIN + 160 * MiB;
constexpr size_t WS_WPIN = WS_WAOUT + 64 * MiB;
constexpr size_t WS_WGRP = WS_WPIN + 256 * MiB;
constexpr size_t WS_WPOUT = WS_WGRP + 64 * MiB;
constexpr size_t WS_WGATE = WS_WPOUT + 128 * MiB;
constexpr size_t WS_WPROJ = WS_WGATE + 128 * MiB;
constexpr size_t WS_PBF = WS_WPROJ + 8 * MiB;
constexpr size_t WS_H = WS_PBF + 32 * MiB;
constexpr size_t WS_H1 = WS_H + 128 * MiB;
constexpr size_t WS_PP = WS_H1 + 128 * MiB;
constexpr size_t WS_ACT = WS_PP + 128 * MiB;
constexpr size_t WS_END = WS_ACT + 768 * MiB;
constexpr size_t WS_WINV = WS_ACT + 512 * MiB;
constexpr size_t ACT_XI8 = 704 * MiB;
constexpr size_t ACT_Q = 0, ACT_K = 128 * MiB, ACT_Z = 160 * MiB, ACT_VT = 288 * MiB, ACT_G = 320 * MiB;
constexpr size_t ACT_V = 0, ACT_PZ = 256 * MiB, ACT_DP = 512 * MiB;

constexpr int CW_BAR = 4096;
constexpr size_t CTL_CMAXP = 2048 * 1024;
constexpr size_t CTL_CMAXA = 1856 * 1024;
constexpr size_t CTL_CMAX = 1792 * 1024;
constexpr size_t CTL_RSS = 512 * 1024;

constexpr int RING_BYTES = 131072;
constexpr int LDS_BYTES = 147456;
constexpr int LDSCTL_OFF = LDS_BYTES - 1024, MISC_OFF = LDSCTL_OFF + 320;

typedef _Float16 half2v __attribute__((ext_vector_type(2)));
__device__ __forceinline__ unsigned cvt_pk_bf16(float lo, float hi) { return __builtin_bit_cast(unsigned, __builtin_convertvector((f32x2){lo, hi}, half2v)); }
__device__ __forceinline__ float bf_lo(unsigned w) { return (float)__builtin_bit_cast(_Float16, (unsigned short)(w & 0xffffu)); }
__device__ __forceinline__ float bf_hi(unsigned w) { return (float)__builtin_bit_cast(_Float16, (unsigned short)(w >> 16)); }
__device__ __forceinline__ float fast_exp2(float x) { return __builtin_amdgcn_exp2f(x); }
__device__ __forceinline__ float fast_rcp(float x) { return __builtin_amdgcn_rcpf(x); }
__device__ __forceinline__ float sigmoidf_(float a) { return fast_rcp(1.0f + fast_exp2(-a * LOG2E)); }
__device__ __forceinline__ float siluf_(float a) { return a * sigmoidf_(a); }
__device__ __forceinline__ int launder_i(int n) { asm volatile("" : "+s"(n)); return n; }
__device__ __forceinline__ float wave_sum(float v) {
#pragma unroll
    for (int o = 1; o < 64; o <<= 1) v += __shfl_xor(v, o);
    return v;
}

__device__ __forceinline__ int lane_id();
namespace pg8 {
typedef unsigned short bf16_t;
constexpr int BM = 256, BK = 64, HALF = 128, HTB = HALF * BK * 2, STAGE_BYTES = 8 * HTB, NXCD = 8, WGM = 8;
__host__ __device__ __forceinline__ int lds_byte(int r, int c) { const int st = (r >> 4) * 2 + (c >> 5), rr = r & 15, cc = c & 31, ob = rr * 64 + cc * 2; return st * 1024 + (ob ^ (((ob >> 9) & 1) << 5)); }
__host__ __device__ __forceinline__ void stage_rc(int b, int& R, int& C) { const int st = b / 1024, sb = b % 1024, swz = sb ^ (((sb >> 9) & 1) << 5); R = (st >> 1) * 16 + swz / 64; C = (st & 1) * 32 + (swz % 64) / 2; }
__host__ __device__ __forceinline__ int perm32(int rho) { const int n = rho >> 4, i = rho & 15; return 8 * (i >> 2) + 4 * n + (i & 3); }

typedef int i32x4v __attribute__((ext_vector_type(4)));
struct Unit { int pm, pn; };
typedef unsigned long long rss_t;
__device__ __forceinline__ float rstd_of(const rss_t* p) { const rss_t v = __hip_atomic_load((const GAS rss_t*)p, __ATOMIC_RELAXED, __HIP_MEMORY_SCOPE_AGENT); return 1.0f / sqrtf((float)v * (1.0f / 16777216.0f / 4096.0f) + 1e-6f); }
__device__ __forceinline__ rss_t ld_rss(const rss_t* p) { return __hip_atomic_load((const GAS rss_t*)p, __ATOMIC_RELAXED, __HIP_MEMORY_SCOPE_AGENT); }
#define PIN8(a) asm volatile("" : "+v"(a[0][0]), "+v"(a[0][1]), "+v"(a[0][2]), "+v"(a[0][3]), "+v"(a[1][0]), "+v"(a[1][1]), "+v"(a[1][2]), "+v"(a[1][3]) :: "memory")
#define PIN4(a) asm volatile("" : "+v"(a[0]), "+v"(a[1]), "+v"(a[2]), "+v"(a[3]) :: "memory")
__device__ __forceinline__ float rstd_v(rss_t v) { return 1.0f / sqrtf((float)v * (1.0f / 16777216.0f / 4096.0f) + 1e-6f); }
constexpr float I8_CLIP = 4.5f;
__device__ __forceinline__ float i8_row_step(const rss_t* p) { const rss_t v = __hip_atomic_load((const GAS rss_t*)p, __ATOMIC_RELAXED, __HIP_MEMORY_SCOPE_AGENT); return sqrtf((float)v * (1.0f / 16777216.0f / 4096.0f)) * (I8_CLIP / 127.0f) + 1e-20f; }
__device__ __forceinline__ float i8_step_v(rss_t v) { return sqrtf((float)v * (1.0f / 16777216.0f / 4096.0f)) * (I8_CLIP / 127.0f) + 1e-20f; }
__device__ __forceinline__ unsigned q8(float x, float inv) { const float r = __builtin_amdgcn_fmed3f(__builtin_rintf(x * inv), -127.0f, 127.0f); return (unsigned)(int)r & 0xffu; }
__device__ __forceinline__ unsigned pack_i8x4(float a, float b, float c, float d, float inv) { return q8(a, inv) | (q8(b, inv) << 8) | (q8(c, inv) << 16) | (q8(d, inv) << 24); }
__device__ __forceinline__ rss_t rss_fix(float v) { return (rss_t)(v * 16777216.0f + 0.5f); }
__device__ __forceinline__ void rss_add(rss_t* p, float v) { (void)__hip_atomic_fetch_add((GAS rss_t*)p, rss_fix(v), __ATOMIC_RELAXED, __HIP_MEMORY_SCOPE_AGENT); }
struct Gemm { const bf16_t* A; const bf16_t* Bt; int lda, ldb, M, N, K, gshift, gcols, bshift, bstride; };

struct StaticOrder {
    int nM, nN, nwg, G, c;
    __host__ __device__ void init(int M, int N, int G_, int c_) { nM = M / BM; nN = N / BM; nwg = nM * nN; G = G_; c = c_; }
    __host__ __device__ bool next(int i, Unit& u) const {
        const long L = (long)i * G + c; if (L >= nwg) return false;
        int wgid = (int)L; { const int q = nwg / NXCD, r = nwg % NXCD, xcd = wgid % NXCD, off = wgid / NXCD; wgid = (xcd < r ? xcd * (q + 1) : r * (q + 1) + (xcd - r) * q) + off; }
        const int nig = WGM * nN, gid = wgid / nig, fm = gid * WGM, gsz = (nM - fm) < WGM ? (nM - fm) : WGM;
        u.pm = fm + ((wgid % nig) % gsz); u.pn = (wgid % nig) / gsz; return true;
    }
};

struct EpiSplit {
    static constexpr bool PERM = true;
    bf16_t* p0; bf16_t* p1; bf16_t* p2; int ld0, ld1, ld2, t1, t2, rshift, rstride;
    const rss_t* rss; int smode;
    unsigned* rowmax; int rmshift, rmstride;
    const unsigned* cmax; const rss_t* rssq;
    __device__ __forceinline__ void operator()(const f32x4 (&acc)[2][2][4][2], const Unit& u, int wr, int wc, int fr, int fq) const {
        bf16_t* base; int ldc, colt;
        if (u.pn < t1) { base = p0; ldc = ld0; colt = u.pn * BM; }
        else if (u.pn < t2) { base = p1; ldc = ld1; colt = (u.pn - t1) * BM; }
        else { base = p2; ldc = ld2; colt = (u.pn - t2) * BM; }
        base += (size_t)(u.pm >> rshift) * rstride;
        const int row0 = u.pm * BM + wr * 64 + fr, col0 = colt + wc * 32 + 8 * fq, gcol0 = u.pn * BM + wc * 32 + 8 * fq;
        f32x4 cs[2][2];
#pragma unroll
        for (int bj = 0; bj < 2; ++bj)
#pragma unroll
            for (int n = 0; n < 2; ++n) { cs[bj][n] = (f32x4){1.f, 1.f, 1.f, 1.f};
                if (smode == 2) {
#pragma unroll
                    for (int e = 0; e < 4; ++e) { const int c = gcol0 + bj * HALF + 4 * n + e; cs[bj][n][e] = rstd_of(rss + c) * (cmax ? i8_row_step(rssq + c) : 1.0f); } }
                else if (cmax) { const u32x4 cm = *(const GAS u32x4*)(cmax + gcol0 + bj * HALF + 4 * n); cs[bj][n] = (f32x4){__uint_as_float(cm.x), __uint_as_float(cm.y), __uint_as_float(cm.z), __uint_as_float(cm.w)} * (1.0f / 127.0f); } }
        float rsv[2][4];
        { rss_t ra[2][4], rq[2][4]; unsigned rc[2][4];
#pragma unroll
          for (int ai = 0; ai < 2; ++ai)
#pragma unroll
              for (int m = 0; m < 4; ++m) { const int row = row0 + ai * HALF + m * 16; ra[ai][m] = 0; rq[ai][m] = 0; rc[ai][m] = 0;
                  if (smode == 1) { ra[ai][m] = ld_rss(rss + row); if (cmax) rq[ai][m] = ld_rss(rssq + row); }
                  else if (cmax) rc[ai][m] = __hip_atomic_load((const GAS unsigned*)cmax + row, __ATOMIC_RELAXED, __HIP_MEMORY_SCOPE_AGENT); }
          PIN8(ra); PIN8(rq);
#pragma unroll
          for (int ai = 0; ai < 2; ++ai)
#pragma unroll
              for (int m = 0; m < 4; ++m) { float rs = 1.f;
                  if (smode == 1) rs = rstd_v(ra[ai][m]) * (cmax ? i8_step_v(rq[ai][m]) : 1.0f);
                  else if (cmax) rs = __uint_as_float(rc[ai][m]) * (1.0f / 127.0f);
                  rsv[ai][m] = rs; } }
#pragma unroll
        for (int ai = 0; ai < 2; ++ai)
#pragma unroll
            for (int m = 0; m < 4; ++m) { const int row = row0 + ai * HALF + m * 16; bf16_t* rowp = base + (size_t)row * ldc + col0;
                const float rs = rsv[ai][m]; float rmx = 0.f;
#pragma unroll
                for (int bj = 0; bj < 2; ++bj) { f32x4 v0 = acc[ai][bj][m][0], v1 = acc[ai][bj][m][1];
                    if (cmax) { v0 = __builtin_convertvector(__builtin_bit_cast(i32x4v, v0), f32x4); v1 = __builtin_convertvector(__builtin_bit_cast(i32x4v, v1), f32x4); }
                    v0 = v0 * cs[bj][0] * rs; v1 = v1 * cs[bj][1] * rs;
                    u32x4 w; w.x = cvt_pk_bf16(v0[0], v0[1]); w.y = cvt_pk_bf16(v0[2], v0[3]); w.z = cvt_pk_bf16(v1[0], v1[1]); w.w = cvt_pk_bf16(v1[2], v1[3]);
                    *(GAS u32x4*)(rowp + bj * HALF) = w;
                    if (rowmax) { const float a = fmaxf(fmaxf(fmaxf(fabsf(bf_lo(w.x)), fabsf(bf_hi(w.x))), fmaxf(fabsf(bf_lo(w.y)), fabsf(bf_hi(w.y)))), fmaxf(fmaxf(fabsf(bf_lo(w.z)), fabsf(bf_hi(w.z))), fmaxf(fabsf(bf_lo(w.w)), fabsf(bf_hi(w.w))))); rmx = fmaxf(rmx, a); } }
                if (rowmax) { rmx = fmaxf(rmx, __shfl_xor(rmx, 16)); rmx = fmaxf(rmx, __shfl_xor(rmx, 32));
                    if (fq == 0) __hip_atomic_fetch_max((GAS unsigned*)rowmax + row + (size_t)(u.pm >> rmshift) * rmstride, __float_as_uint(rmx), __ATOMIC_RELAXED, __HIP_MEMORY_SCOPE_AGENT); } }
    }
};
struct EpiRes {
    static constexpr bool PERM = true;
    const bf16_t* base; bf16_t* xb; rss_t* rss; int ldc; unsigned char* xb8; int q8mode; const rss_t* rss0;
    __device__ __forceinline__ void operator()(const f32x4 (&acc)[2][2][4][2], const Unit& u, int wr, int wc, int fr, int fq) const {
        const int row0 = u.pm * BM + wr * 64 + fr, col0 = u.pn * BM + wc * 32 + 8 * fq;
        float qinvv[2][4];
        { rss_t r0v[2][4];
#pragma unroll
          for (int ai = 0; ai < 2; ++ai)
#pragma unroll
              for (int m = 0; m < 4; ++m) r0v[ai][m] = (xb8 && q8mode == 2) ? ld_rss(rss0 + row0 + ai * HALF + m * 16) : (rss_t)0;
          PIN8(r0v);
#pragma unroll
          for (int ai = 0; ai < 2; ++ai)
#pragma unroll
              for (int m = 0; m < 4; ++m) qinvv[ai][m] = (xb8 && q8mode == 2) ? 1.0f / i8_step_v(r0v[ai][m]) : 0.f; }
#pragma unroll
        for (int ai = 0; ai < 2; ++ai) {
            u32x4 b[4][2];
#pragma unroll
            for (int m = 0; m < 4; ++m)
#pragma unroll
                for (int bj = 0; bj < 2; ++bj) b[m][bj] = *(const GAS u32x4*)(base + (size_t)(row0 + ai * HALF + m * 16) * ldc + col0 + bj * HALF);
#pragma unroll
            for (int m = 0; m < 4; ++m) { const int row = row0 + ai * HALF + m * 16; const size_t off = (size_t)row * ldc + col0;
                float ss = 0.f; const float qinv = qinvv[ai][m];
#pragma unroll
                for (int bj = 0; bj < 2; ++bj) { const f32x4 a0 = acc[ai][bj][m][0], a1 = acc[ai][bj][m][1]; const u32x4 q = b[m][bj];
                    u32x4 w; w.x = cvt_pk_bf16(bf_lo(q.x) + a0[0], bf_hi(q.x) + a0[1]); w.y = cvt_pk_bf16(bf_lo(q.y) + a0[2], bf_hi(q.y) + a0[3]);
                    w.z = cvt_pk_bf16(bf_lo(q.z) + a1[0], bf_hi(q.z) + a1[1]); w.w = cvt_pk_bf16(bf_lo(q.w) + a1[2], bf_hi(q.w) + a1[3]);
                    *(GAS u32x4*)(xb + off + bj * HALF) = w;
                    const float r0 = bf_lo(w.x), r1 = bf_hi(w.x), r2 = bf_lo(w.y), r3 = bf_hi(w.y), r4 = bf_lo(w.z), r5 = bf_hi(w.z), r6 = bf_lo(w.w), r7 = bf_hi(w.w);
                    ss += (r0 * r0 + r1 * r1) + (r2 * r2 + r3 * r3) + (r4 * r4 + r5 * r5) + (r6 * r6 + r7 * r7);
                    if (xb8 && q8mode == 2) { *(GAS u32x2*)(xb8 + off + bj * HALF) = (u32x2){pack_i8x4(r0, r1, r2, r3, qinv), pack_i8x4(r4, r5, r6, r7, qinv)}; }
                    else if (xb8) { unsigned p0 = 0u, p1 = 0u;
                        p0 = __builtin_amdgcn_cvt_pk_fp8_f32(r0 * 8.f, r1 * 8.f, p0, false); p0 = __builtin_amdgcn_cvt_pk_fp8_f32(r2 * 8.f, r3 * 8.f, p0, true);
                        p1 = __builtin_amdgcn_cvt_pk_fp8_f32(r4 * 8.f, r5 * 8.f, p1, false); p1 = __builtin_amdgcn_cvt_pk_fp8_f32(r6 * 8.f, r7 * 8.f, p1, true);
                        *(GAS u32x2*)(xb8 + off + bj * HALF) = (u32x2){p0, p1}; } }
                ss += __shfl_xor(ss, 16); ss += __shfl_xor(ss, 32);
                if (fq == 0) rss_add(rss + row, ss); }
            asm volatile("" ::: "memory"); }
    }
};
struct EpiGate {
    static constexpr bool PERM = true;
    const bf16_t* x; const bf16_t* pp; const rss_t* rss_in; bf16_t* xb; rss_t* rss; float* outf; int ldc; float lscale; const unsigned* cmax; const rss_t* rss0; unsigned char* xq8;
    __device__ __forceinline__ void operator()(const f32x4 (&acc)[2][2][4][2], const Unit& u, int wr, int wc, int fr, int fq) const {
        const int row0 = u.pm * BM + wr * 64 + fr, col0 = u.pn * BM + wc * 32 + 8 * fq;
        f32x4 cs[2][2];
#pragma unroll
        for (int bj = 0; bj < 2; ++bj)
#pragma unroll
            for (int n = 0; n < 2; ++n) { cs[bj][n] = (f32x4){1.f, 1.f, 1.f, 1.f};
                if (cmax) { const u32x4 cm = *(const GAS u32x4*)(cmax + col0 + bj * HALF + 4 * n); cs[bj][n] = (f32x4){__uint_as_float(cm.x), __uint_as_float(cm.y), __uint_as_float(cm.z), __uint_as_float(cm.w)} * (1.0f / 127.0f); } }
#pragma unroll
        for (int ai = 0; ai < 2; ++ai) {
            float rsv[4], qinvv[4];
            { rss_t rin[4], r0v[4];
#pragma unroll
              for (int m = 0; m < 4; ++m) { const int row = row0 + ai * HALF + m * 16; rin[m] = ld_rss(rss_in + row); r0v[m] = cmax ? ld_rss(rss0 + row) : (rss_t)0; }
              PIN4(rin); PIN4(r0v);
#pragma unroll
              for (int m = 0; m < 4; ++m) { rsv[m] = rstd_v(rin[m]) * (cmax ? i8_step_v(r0v[m]) : lscale); qinvv[m] = xq8 ? 1.0f / i8_step_v(rin[m]) : 0.f; } }
#pragma unroll
            for (int mh = 0; mh < 2; ++mh) {
                u32x4 b[2][2], q[2][2]; float rs[2];
#pragma unroll
                for (int ml = 0; ml < 2; ++ml) { const int row = row0 + ai * HALF + (2 * mh + ml) * 16; rs[ml] = rsv[2 * mh + ml];
#pragma unroll
                    for (int bj = 0; bj < 2; ++bj) { b[ml][bj] = *(const GAS u32x4*)(x + (size_t)row * ldc + col0 + bj * HALF); q[ml][bj] = *(const GAS u32x4*)(pp + (size_t)row * ldc + col0 + bj * HALF); } }
#pragma unroll
                for (int ml = 0; ml < 2; ++ml) { const int m = 2 * mh + ml, row = row0 + ai * HALF + m * 16; const size_t off = (size_t)row * ldc + col0;
                    float ss = 0.f; const float qinv = qinvv[m];
#pragma unroll
                    for (int bj = 0; bj < 2; ++bj) { f32x4 a0 = acc[ai][bj][m][0], a1 = acc[ai][bj][m][1];
                        if (cmax) { a0 = __builtin_convertvector(__builtin_bit_cast(i32x4v, a0), f32x4) * cs[bj][0]; a1 = __builtin_convertvector(__builtin_bit_cast(i32x4v, a1), f32x4) * cs[bj][1]; }
                        a0 = a0 * rs[ml]; a1 = a1 * rs[ml]; const u32x4 xx = b[ml][bj], pq = q[ml][bj]; f32x4 v0, v1;
                        v0[0] = bf_lo(xx.x) + bf_lo(pq.x) * sigmoidf_(a0[0]); v0[1] = bf_hi(xx.x) + bf_hi(pq.x) * sigmoidf_(a0[1]);
                        v0[2] = bf_lo(xx.y) + bf_lo(pq.y) * sigmoidf_(a0[2]); v0[3] = bf_hi(xx.y) + bf_hi(pq.y) * sigmoidf_(a0[3]);
                        v1[0] = bf_lo(xx.z) + bf_lo(pq.z) * sigmoidf_(a1[0]); v1[1] = bf_hi(xx.z) + bf_hi(pq.z) * sigmoidf_(a1[1]);
                        v1[2] = bf_lo(xx.w) + bf_lo(pq.w) * sigmoidf_(a1[2]); v1[3] = bf_hi(xx.w) + bf_hi(pq.w) * sigmoidf_(a1[3]);
                        if (xb) {
                            u32x4 w; w.x = cvt_pk_bf16(v0[0], v0[1]); w.y = cvt_pk_bf16(v0[2], v0[3]); w.z = cvt_pk_bf16(v1[0], v1[1]); w.w = cvt_pk_bf16(v1[2], v1[3]);
                            *(GAS u32x4*)(xb + off + bj * HALF) = w;
                            const float r0 = bf_lo(w.x), r1 = bf_hi(w.x), r2 = bf_lo(w.y), r3 = bf_hi(w.y), r4 = bf_lo(w.z), r5 = bf_hi(w.z), r6 = bf_lo(w.w), r7 = bf_hi(w.w);
                            ss += (r0 * r0 + r1 * r1) + (r2 * r2 + r3 * r3) + (r4 * r4 + r5 * r5) + (r6 * r6 + r7 * r7);
                            if (xq8) *(GAS u32x2*)(xq8 + off + bj * HALF) = (u32x2){pack_i8x4(r0, r1, r2, r3, qinv), pack_i8x4(r4, r5, r6, r7, qinv)};
                        } else { *(GAS f32x4*)(outf + off + bj * HALF) = v0; *(GAS f32x4*)(outf + off + bj * HALF + 4) = v1; } }
                    if (xb) { ss += __shfl_xor(ss, 16); ss += __shfl_xor(ss, 32); if (fq == 0) rss_add(rss + row, ss); } }
                asm volatile("" ::: "memory"); } }
    }
};
struct EpiGrp {
    static constexpr bool PERM = true;
    bf16_t* O; const bf16_t* z; const float* scale; int ldc;
    __device__ __forceinline__ void operator()(const f32x4 (&acc)[2][2][4][2], const Unit& u, int wr, int wc, int fr, int fq) const {
        const int row0 = u.pm * BM + wr * 64 + fr, col0 = u.pn * BM + wc * 32 + 8 * fq;
        f32x4 sc[2][2];
#pragma unroll
        for (int bj = 0; bj < 2; ++bj)
#pragma unroll
            for (int n = 0; n < 2; ++n) sc[bj][n] = *(const GAS f32x4*)(scale + col0 + bj * HALF + 4 * n);
#pragma unroll
        for (int ai = 0; ai < 2; ++ai)
#pragma unroll
            for (int m = 0; m < 4; ++m) { const size_t off = (size_t)(row0 + ai * HALF + m * 16) * ldc + col0;
                u32x4 zz[2];
#pragma unroll
                for (int bj = 0; bj < 2; ++bj) zz[bj] = *(const GAS u32x4*)(z + off + bj * HALF);
#pragma unroll
                for (int bj = 0; bj < 2; ++bj) { const f32x4 v0 = acc[ai][bj][m][0] * sc[bj][0], v1 = acc[ai][bj][m][1] * sc[bj][1]; const u32x4 zw = zz[bj];
                    u32x4 w;
                    w.x = cvt_pk_bf16(v0[0] * siluf_(bf_lo(zw.x)), v0[1] * siluf_(bf_hi(zw.x))); w.y = cvt_pk_bf16(v0[2] * siluf_(bf_lo(zw.y)), v0[3] * siluf_(bf_hi(zw.y)));
                    w.z = cvt_pk_bf16(v1[0] * siluf_(bf_lo(zw.z)), v1[1] * siluf_(bf_hi(zw.z))); w.w = cvt_pk_bf16(v1[2] * siluf_(bf_lo(zw.w)), v1[3] * siluf_(bf_hi(zw.w)));
                    *(GAS u32x4*)(O + off + bj * HALF) = w; }
                if (m & 1) asm volatile("" ::: "memory"); }
    }
};

typedef int i32x8 __attribute__((ext_vector_type(8)));
__device__ __forceinline__ i32x8 cat8(const bf16x8 a, const bf16x8 b) { const i32x4v x = __builtin_bit_cast(i32x4v, a), y = __builtin_bit_cast(i32x4v, b); return (i32x8){x[0], x[1], x[2], x[3], y[0], y[1], y[2], y[3]}; }
template <class Epi, bool ALIGN_EPI = true, int MODE = 0>
__device__ __forceinline__ void gemm_phase(LAS unsigned char* lds, const Gemm g, const StaticOrder& S, const Epi& E, const int tid_in) {
    constexpr bool FP8 = (MODE == 1), I8 = (MODE == 2);
    int tid = tid_in; asm volatile("" : "+v"(tid));
    const int wid = __builtin_amdgcn_readfirstlane(tid >> 6), lane = tid & 63, wr = wid >> 2, wc = wid & 3, fr = lane & 15, fq = lane >> 4;
    const int K = g.K, nt = K / BK;
    unsigned voffA[2], voffB[2];
#pragma unroll
    for (int i = 0; i < 2; ++i) { int R, C; stage_rc(tid * 16 + i * 8192, R, C); const int Rb = Epi::PERM ? ((R & ~31) + perm32(R & 31)) : R;
        voffA[i] = (unsigned)(R * g.lda + C) * 2u; voffB[i] = (unsigned)(Rb * g.ldb + C) * 2u; }
    const size_t kstep = (size_t)(BK * 2);
    const size_t hstepA = (size_t)HALF * g.lda * 2, hstepB = (size_t)HALF * g.ldb * 2;
    const size_t tstepA = 2 * hstepA, tstepB = 2 * hstepB;
    const unsigned ldsw = (unsigned)wid * 1024u;
    const int aoff = lds_byte(wr * 64 + fr, fq * 8), boff = lds_byte(wc * 32 + fr, fq * 8);
#define PG8_SA(b, h) (((b) * 2 + (h)) * HTB)
#define PG8_SB(b, h) ((4 + (b) * 2 + (h)) * HTB)
#define PG8_STAGE(bufoff, gbase, voff) do { _Pragma("unroll") for (int _i = 0; _i < 2; ++_i) \
        { if constexpr (FP8) __builtin_amdgcn_global_load_lds((const GAS unsigned*)((const GAS char*)(gbase) + (voff)[_i]), (LAS unsigned*)(lds + (bufoff) + ldsw + _i * 8192), 16, 0, 0);   \
          else __builtin_amdgcn_global_load_lds((const unsigned*)((const char*)(gbase) + (voff)[_i]), (LAS unsigned*)(lds + (bufoff) + ldsw + _i * 8192), 16, 0, 0); } } while (0)
#define PG8_LD8(p) __builtin_shufflevector(*(const LAS i32x4v*)(p), *(const LAS i32x4v*)((p) + 1024), 0, 1, 2, 3, 4, 5, 6, 7)
#define PG8_LDA(dst, b, h) do { if constexpr (FP8) { _Pragma("unroll") for (int m = 0; m < 4; ++m) dst##8[m] = PG8_LD8(lds + PG8_SA(b, h) + aoff + m * 2048); } else { _Pragma("unroll") for (int m = 0; m < 4; ++m) _Pragma("unroll") for (int k = 0; k < 2; ++k) dst[m][k] = *(const LAS bf16x8*)(lds + PG8_SA(b, h) + aoff + m * 2048 + k * 1024); } } while (0)
#define PG8_LDB(dst, b, h) do { if constexpr (FP8) { _Pragma("unroll") for (int n = 0; n < 2; ++n) dst##8[n] = PG8_LD8(lds + PG8_SB(b, h) + boff + n * 2048); } else { _Pragma("unroll") for (int n = 0; n < 2; ++n) _Pragma("unroll") for (int k = 0; k < 2; ++k) dst[n][k] = *(const LAS bf16x8*)(lds + PG8_SB(b, h) + boff + n * 2048 + k * 1024); } } while (0)
#define PG8_MMA(ai, bj, At, Bt) do { __builtin_amdgcn_s_setprio(0);   if constexpr (FP8) { _Pragma("unroll") for (int m = 0; m < 4; ++m) _Pragma("unroll") for (int n = 0; n < 2; ++n) \
        asm volatile("v_mfma_scale_f32_16x16x128_f8f6f4 %0, %1, %2, %0, %3, %3 op_sel_hi:[0,0,0]" : "+v"(acc[ai][bj][m][n]) : "v"(Bt##8[n]), "v"(At##8[m]), "v"(0x7F7F7F7F)); } else { \
        _Pragma("unroll") for (int m = 0; m < 4; ++m) _Pragma("unroll") for (int n = 0; n < 2; ++n) _Pragma("unroll") for (int k = 0; k < 2; ++k) { \
        if constexpr (I8) acc[ai][bj][m][n] = __builtin_bit_cast(f32x4, __builtin_amdgcn_mfma_i32_16x16x64_i8(__builtin_bit_cast(i32x4v, Bt[n][k]), __builtin_bit_cast(i32x4v, At[m][k]), __builtin_bit_cast(i32x4v, acc[ai][bj][m][n]), 0, 0, 0)); \
        else acc[ai][bj][m][n] = __builtin_amdgcn_mfma_f32_16x16x32_f16(Bt[n][k], At[m][k], acc[ai][bj][m][n], 0, 0, 0); } } __builtin_amdgcn_s_setprio(0); } while (0)
#define PG8_WAIT_V(n) asm volatile("s_waitcnt vmcnt(" #n ")" ::: "memory")
#define PG8_WAIT_L(n) asm volatile("s_waitcnt lgkmcnt(" #n ")" ::: "memory")
#define PG8_BAR __builtin_amdgcn_s_barrier()
#define PG8_SCHED __builtin_amdgcn_sched_barrier(0)
#define PG8_ABASE(u) ((const char*)g.A + (size_t)(u).pm * tstepA + (size_t)((u).pn >> g.gshift) * g.gcols * 2)
#define PG8_BBASE(u) ((const char*)g.Bt + (size_t)(u).pn * tstepB + (size_t)((u).pm >> g.bshift) * g.bstride * 2)
    Unit cur, nxt; int ui = 0;
    if (!S.next(0, cur)) return;
    f32x4 acc[2][2][4][2];
#pragma unroll
    for (int a = 0; a < 2; ++a)
#pragma unroll
        for (int b = 0; b < 2; ++b)
#pragma unroll
            for (int m = 0; m < 4; ++m)
#pragma unroll
                for (int n = 0; n < 2; ++n) acc[a][b][m][n] = (f32x4){0.f, 0.f, 0.f, 0.f};
    bf16x8 At[4][2], B0[2][2], B1[2][2]; i32x8 At8[4], B08[2], B18[2];
    const char* cA = PG8_ABASE(cur); const char* cB = PG8_BBASE(cur);
    PG8_STAGE(PG8_SB(0, 0), cB, voffB); PG8_STAGE(PG8_SB(0, 1), cB + hstepB, voffB); PG8_STAGE(PG8_SA(0, 0), cA, voffA); PG8_STAGE(PG8_SA(0, 1), cA + hstepA, voffA);
    if (wr == 1) PG8_BAR;
    PG8_WAIT_V(2); PG8_BAR;
    PG8_STAGE(PG8_SB(1, 0), cB + kstep, voffB); PG8_STAGE(PG8_SA(1, 0), cA + kstep, voffA); PG8_STAGE(PG8_SB(1, 1), cB + hstepB + kstep, voffB);
    PG8_WAIT_V(6); PG8_BAR;
    for (;;) {
        const bool has_next = S.next(ui + 1, nxt);
        const char* nA = has_next ? PG8_ABASE(nxt) : cA; const char* nB = has_next ? PG8_BBASE(nxt) : cB;
        const long kinc = (ui & 1) ? -(long)kstep : (long)kstep, nkinc = has_next ? -kinc : kinc;
        const char* sA = cA + ((ui & 1) ? (size_t)(nt - 1) * kstep : 0); const char* sB = cB + ((ui & 1) ? (size_t)(nt - 1) * kstep : 0);
        const char* nsA = has_next ? nA + ((ui & 1) ? 0 : (size_t)(nt - 1) * kstep) : sA; const char* nsB = has_next ? nB + ((ui & 1) ? 0 : (size_t)(nt - 1) * kstep) : sB;
        const char* pA = sA; const char* pB = sB;
        for (int t = 0; t < nt; t += 2, pA += 2 * kinc, pB += 2 * kinc) {
            const bool last = (t == nt - 2);
            const char* a1 = pA + kinc;
            const char* a2 = last ? nsA : pA + 2 * kinc; const char* b2 = last ? nsB : pB + 2 * kinc;
            const char* a3 = a2 + (last ? nkinc : kinc); const char* b3 = b2 + (last ? nkinc : kinc);
            PG8_LDB(B0, 0, 0); PG8_LDB(B1, 0, 1); PG8_SCHED; PG8_LDA(At, 0, 0); PG8_STAGE(PG8_SA(1, 1), a1 + hstepA, voffA);
            PG8_WAIT_V(8); PG8_WAIT_L(0); PG8_BAR; PG8_MMA(0, 0, At, B0); PG8_MMA(0, 1, At, B1); PG8_BAR; PG8_SCHED;
            PG8_LDA(At, 0, 1); PG8_STAGE(PG8_SB(0, 0), b2, voffB); PG8_STAGE(PG8_SB(0, 1), b2 + hstepB, voffB); PG8_STAGE(PG8_SA(0, 0), a2, voffA);
            PG8_WAIT_V(8); PG8_WAIT_L(0); PG8_BAR; PG8_MMA(1, 0, At, B0); PG8_MMA(1, 1, At, B1); PG8_BAR; PG8_SCHED;
            PG8_LDB(B0, 1, 0); PG8_LDB(B1, 1, 1); PG8_SCHED; PG8_LDA(At, 1, 0); PG8_STAGE(PG8_SA(0, 1), a2 + hstepA, voffA);
            PG8_WAIT_V(8); PG8_WAIT_L(0); PG8_BAR; PG8_MMA(0, 0, At, B0); PG8_MMA(0, 1, At, B1); PG8_BAR; PG8_SCHED;
            PG8_LDA(At, 1, 1); PG8_STAGE(PG8_SB(1, 0), b3, voffB); PG8_STAGE(PG8_SB(1, 1), b3 + hstepB, voffB); PG8_STAGE(PG8_SA(1, 0), a3, voffA);
            PG8_WAIT_V(8); PG8_WAIT_L(0); PG8_BAR; PG8_MMA(1, 0, At, B0); PG8_MMA(1, 1, At, B1); PG8_BAR; PG8_SCHED;
        }
        if constexpr (FP8) asm volatile("s_nop 15\n\ts_nop 15" ::: "memory");
        if constexpr (ALIGN_EPI) { if (wr == 0) PG8_BAR; }
        if constexpr (FP8) { const int le = lane_id(); E(acc, cur, wr, wc, le & 15, le >> 4); } else E(acc, cur, wr, wc, fr, fq);
        if (!has_next) break;
#pragma unroll
        for (int a = 0; a < 2; ++a)
#pragma unroll
            for (int b = 0; b < 2; ++b)
#pragma unroll
                for (int m = 0; m < 4; ++m)
#pragma unroll
                    for (int n = 0; n < 2; ++n) acc[a][b][m][n] = (f32x4){0.f, 0.f, 0.f, 0.f};
        cur = nxt; cA = nA; cB = nB; ++ui;
        if constexpr (ALIGN_EPI) { if (wr == 1) PG8_BAR; }
    }
    PG8_WAIT_V(0);
    if constexpr (!ALIGN_EPI) { if (wr == 0) PG8_BAR; }
    PG8_BAR;
#undef PG8_SA
#undef PG8_SB
#undef PG8_STAGE
#undef PG8_LDA
#undef PG8_LDB
#undef PG8_MMA
#undef PG8_WAIT_V
#undef PG8_WAIT_L
#undef PG8_BAR
#undef PG8_SCHED
#undef PG8_ABASE
#undef PG8_BBASE
}
}

#define XB_TMO      128
#define XB_XCNT(j)  (256  + 64 * (j))
#define XB_XSUB(j)  (1280 + 64 * (j))
#define XB_XGEN(j)  (2304 + 64 * (j))
#define XB_TOP      3328
#define XB_TOPGEN   3392
#define XCD_BAR_WORDS 3456
#define XB_SPIN_CAP (1u << 18)

__device__ __forceinline__ unsigned xb_ld(unsigned* p)              { return __hip_atomic_load(p, __ATOMIC_RELAXED, __HIP_MEMORY_SCOPE_AGENT); }
__device__ __forceinline__ unsigned xb_add(unsigned* p, unsigned v) { return __hip_atomic_fetch_add(p, v, __ATOMIC_RELAXED, __HIP_MEMORY_SCOPE_AGENT); }
__device__ __forceinline__ unsigned xb_xcc_id() { return (unsigned)__builtin_amdgcn_s_getreg((3 << 11) | 20) & 0xFu; }
#define XB_SPIN(cond, bar) do { unsigned _sp = 0; while (cond) { __builtin_amdgcn_s_sleep(1); \
    if ((++_sp & 255u) == 0u) { if (xb_ld(&(bar)[XB_TMO])) break; if (_sp > XB_SPIN_CAP) { atomicAdd(&(bar)[XB_TMO], 1u); break; } } } } while (0)

struct XcdBarrier {
    unsigned* bar; unsigned x;
    volatile LAS unsigned* st;
    int wave;
};
__device__ __forceinline__ int lane_id() { unsigned m = ~0u; asm volatile("" : "+s"(m)); return (int)__builtin_amdgcn_mbcnt_hi(m, __builtin_amdgcn_mbcnt_lo(m, 0u)); }
#define XB_T0(b) ((b).wave == 0 && lane_id() == 0)
__device__ __forceinline__ XcdBarrier xcd_barrier_post(unsigned* bar, volatile LAS unsigned* st, int wave) {
    XcdBarrier b; b.bar = bar; b.x = xb_xcc_id(); b.st = st; b.wave = wave;
    if (XB_T0(b)) (void)xb_add(&bar[XB_XCNT(b.x)], 1u);
    return b;
}
__device__ __forceinline__ void xcd_barrier_complete(unsigned* bar, unsigned x, unsigned& nloc, unsigned& nx) {
    const unsigned G = gridDim.x * gridDim.y * gridDim.z;
    unsigned sum, cnt, mine, sp = 0u;
    for (;;) {
        sum = 0u; cnt = 0u; mine = 0u;
#pragma unroll
        for (unsigned j = 0; j < 16; ++j) { const unsigned c = xb_ld(&bar[XB_XCNT(j)]); sum += c; cnt += (c > 0u) ? 1u : 0u; mine = (j == x) ? c : mine; }
        if (sum == G) break;
        __builtin_amdgcn_s_sleep(1);
        if ((++sp & 255u) == 0u) { if (xb_ld(&bar[XB_TMO])) break; if (sp > XB_SPIN_CAP) { atomicAdd(&bar[XB_TMO], 1u); break; } }
    }
    nloc = mine > 0u ? mine : 1u; nx = cnt > 0u ? cnt : 1u;
}
__device__ __forceinline__ void xcd_barrier(const XcdBarrier& b) {
    asm volatile("s_waitcnt vmcnt(0)" ::: "memory");
    __syncthreads();
    if (XB_T0(b)) {
        unsigned* bar = b.bar;
        __builtin_amdgcn_s_waitcnt(0);
        unsigned nloc = b.st[0], nx = b.st[1];
        if (nloc == 0u) { xcd_barrier_complete(bar, b.x, nloc, nx); b.st[0] = nloc; b.st[1] = nx; }
        const unsigned old = xb_add(&bar[XB_XSUB(b.x)], 1u);
        const unsigned gen = old / nloc;
        if (old + 1u == (gen + 1u) * nloc) {
            __builtin_amdgcn_fence(__ATOMIC_RELEASE, "agent");
            asm volatile("s_waitcnt vmcnt(0)" ::: "memory");
            const unsigned og = xb_add(&bar[XB_TOP], 1u);
            const unsigned tg = og / nx;
            if (og + 1u == (tg + 1u) * nx) xb_add(&bar[XB_TOPGEN], 1u);
            else XB_SPIN(xb_ld(&bar[XB_TOPGEN]) == tg, bar);
            __builtin_amdgcn_fence(__ATOMIC_ACQUIRE, "agent");
            xb_add(&bar[XB_XGEN(b.x)], 1u);
            asm volatile("s_waitcnt vmcnt(0)" ::: "memory");
        } else {
            XB_SPIN(xb_ld(&bar[XB_XGEN(b.x)]) == gen, bar);
            __builtin_amdgcn_fence(__ATOMIC_ACQUIRE, "agent");
            asm volatile("s_waitcnt vmcnt(0)" ::: "memory");
        }
    }
    __syncthreads();
}

__device__ __forceinline__ unsigned f2bf(float f) { unsigned u = __builtin_bit_cast(unsigned, f); return (u + 0x7fffu + ((u >> 16) & 1u)) >> 16; }
__device__ __forceinline__ unsigned pk2(float lo, float hi) { return f2bf(lo) | (f2bf(hi) << 16); }
__device__ __forceinline__ void transpose_batch(const float* W, int nbatch, int K, int N, bf16* WT, int remap, LAS float* scr, int gw, int NGW, int lane, int nb_lo = 0, int nb_cnt = -1, const float* gk = nullptr, int gstride = 0, unsigned f8mask = 0u, unsigned i8mask = 0u, const unsigned* cmax = nullptr) {
    const int nblk = nb_cnt < 0 ? N / 32 : nb_cnt, kblk = K / 64, per = nblk * kblk, total = per * nbatch;
    const int rr = lane >> 3, c4 = lane & 7;
    f32x4 cur[8], nxt[8]; float gc[8], gn[8];
#define TB_DECODE(it_, b_, k0_, nb_) const int b_ = (it_) / per, _r##b_ = (it_) - b_ * per, _kb##b_ = _r##b_ / nblk, nb_ = nb_lo + (_r##b_ - _kb##b_ * nblk), k0_ = 64 * _kb##b_
#define TB_LOAD(dst, gd, b_, k0_, nb_) do { const GAS char* _ub = (const GAS char*)W + ((size_t)(b_) * K * N + (size_t)(k0_) * N + 32 * (nb_)) * 4;     \
        int _rr = rr; asm volatile("" : "+v"(_rr)); const unsigned _vo = (unsigned)(_rr * N + 4 * c4) * 4u;     \
        _Pragma("unroll") for (int i = 0; i < 8; ++i) dst[i] = *(const GAS f32x4*)(_ub + (size_t)(8 * i) * N * 4 + _vo); \
        if (gk) { const GAS float* _g = (const GAS float*)gk + (size_t)(b_) * gstride + (k0_) + rr; _Pragma("unroll") for (int i = 0; i < 8; ++i) gd[i] = _g[8 * i]; } \
        else { _Pragma("unroll") for (int i = 0; i < 8; ++i) gd[i] = 1.0f; } } while (0)
    int it = gw;
    if (it < total) { TB_DECODE(it, b0, k00, nb0); TB_LOAD(cur, gc, b0, k00, nb0); }
    while (it < total) {
        const int itn = it + NGW;
        if (itn < total) { TB_DECODE(itn, b1, k01, nb1); TB_LOAD(nxt, gn, b1, k01, nb1); }
        TB_DECODE(it, b, k0, nb);
        int drow0 = 32 * nb;
        if (remap) { if (drow0 >= 6144) drow0 -= 1024; else if (drow0 >= 5120) drow0 += 4096; }
#pragma unroll
        for (int i = 0; i < 8; ++i) { LAS float* s = scr + (8 * i + rr) * 33 + 4 * c4; const f32x4 v = cur[i] * gc[i]; s[0] = v[0]; s[1] = v[1]; s[2] = v[2]; s[3] = v[3]; }
        asm volatile("s_waitcnt lgkmcnt(0)" ::: "memory");
        { const int c = lane & 7; bf16* wt = WT + (size_t)b * K * N;
          if ((i8mask >> b) & 1u) {
#pragma unroll
              for (int j = 0; j < 4; ++j) { const int n = (lane >> 3) + 8 * j; const LAS float* s = scr + (8 * c) * 33 + n;
                  const float cm = __uint_as_float(__hip_atomic_load((const GAS unsigned*)cmax + (size_t)b * N + drow0 + n, __ATOMIC_RELAXED, __HIP_MEMORY_SCOPE_AGENT)), inv = cm > 0.f ? 127.0f / cm : 0.f;
                  *(GAS u32x2*)((unsigned char*)wt + (size_t)(drow0 + n) * K + k0 + 8 * c) = (u32x2){pg8::pack_i8x4(s[0 * 33], s[1 * 33], s[2 * 33], s[3 * 33], inv), pg8::pack_i8x4(s[4 * 33], s[5 * 33], s[6 * 33], s[7 * 33], inv)}; }
          } else if ((f8mask >> b) & 1u) {
#pragma unroll
              for (int j = 0; j < 4; ++j) { const int n = (lane >> 3) + 8 * j; const LAS float* s = scr + (8 * c) * 33 + n; unsigned p0 = 0u, p1 = 0u;
                  p0 = __builtin_amdgcn_cvt_pk_fp8_f32(s[0 * 33] * 64.f, s[1 * 33] * 64.f, p0, false); p0 = __builtin_amdgcn_cvt_pk_fp8_f32(s[2 * 33] * 64.f, s[3 * 33] * 64.f, p0, true);
                  p1 = __builtin_amdgcn_cvt_pk_fp8_f32(s[4 * 33] * 64.f, s[5 * 33] * 64.f, p1, false); p1 = __builtin_amdgcn_cvt_pk_fp8_f32(s[6 * 33] * 64.f, s[7 * 33] * 64.f, p1, true);
                  *(GAS u32x2*)((unsigned char*)wt + (size_t)(drow0 + n) * K + k0 + 8 * c) = (u32x2){p0, p1}; }
          } else {
#pragma unroll
          for (int j = 0; j < 4; ++j) { const int n = (lane >> 3) + 8 * j; const LAS float* s = scr + (8 * c) * 33 + n;
              u32x4 o; o.x = cvt_pk_bf16(s[0 * 33], s[1 * 33]); o.y = cvt_pk_bf16(s[2 * 33], s[3 * 33]); o.z = cvt_pk_bf16(s[4 * 33], s[5 * 33]); o.w = cvt_pk_bf16(s[6 * 33], s[7 * 33]);
              *(GAS u32x4*)(wt + (size_t)(drow0 + n) * K + k0 + 8 * c) = o; } } }
        asm volatile("s_waitcnt lgkmcnt(0)" ::: "memory");
#pragma unroll
        for (int i = 0; i < 8; ++i) { cur[i] = nxt[i]; gc[i] = gn[i]; }
        it = itn;
    }
#undef TB_DECODE
#undef TB_LOAD
}
__device__ __forceinline__ void i8w_fused(const float* W, int nbat, unsigned bmask, int K, int ldw, int nb_lo, int nblk, int remap, const float* gk, int gstride, unsigned char* WTb, size_t wt_bstride, unsigned* cmax, int ostride, LAS unsigned char* lds, int vcu, int G, int tid_in, int task0 = 0) {
    int tid = tid_in; asm volatile("" : "+v"(tid));
    const int wave = __builtin_amdgcn_readfirstlane(tid >> 6), lane = tid & 63, rr = lane >> 3, c4 = lane & 7, kblk = K / 64;
    LAS float* scr = (LAS float*)(lds + wave * 16384); LAS float* cmw = (LAS float*)(lds + 131072); LAS float* cmf = cmw + 256;
    int first = vcu - (task0 % G); if (first < 0) first += G;
    for (int task = first; task < nbat * nblk; task += G) {
        const int b = task / nblk, nb = nb_lo + (task - b * nblk);
        if (!((bmask >> b) & 1u)) continue;
        int drow0 = 32 * nb;
        if (remap) { if (drow0 >= 6144) drow0 -= 1024; else if (drow0 >= 5120) drow0 += 4096; }
        const GAS char* ub = (const GAS char*)W + ((size_t)b * K * ldw + 32 * nb) * 4;
        const GAS float* gb = (const GAS float*)gk + (size_t)b * gstride;
#define I8F_LOAD(dst, gd, kb_) do { int _rr = rr; asm volatile("" : "+v"(_rr)); const unsigned _vo = (unsigned)(_rr * ldw + 4 * c4) * 4u; const GAS char* _ub = ub + (size_t)(kb_) * 64 * ldw * 4; \
        _Pragma("unroll") for (int i = 0; i < 8; ++i) dst[i] = *(const GAS f32x4*)(_ub + (size_t)(8 * i) * ldw * 4 + _vo); \
        _Pragma("unroll") for (int i = 0; i < 8; ++i) gd[i] = gb[(kb_) * 64 + 8 * i + _rr]; } while (0)
        f32x4 mx = (f32x4){0.f, 0.f, 0.f, 0.f};
        { f32x4 va[8], vb[8]; float ga[8], gbv[8];
#pragma nounroll
          for (int kb = wave; kb < kblk; kb += 16) {
              I8F_LOAD(va, ga, kb);
              const bool two = kb + 8 < kblk;
              if (two) I8F_LOAD(vb, gbv, kb + 8);
#pragma unroll
              for (int i = 0; i < 8; ++i) mx = __builtin_elementwise_max(mx, __builtin_elementwise_abs(va[i] * ga[i]));
              if (two) {
#pragma unroll
                  for (int i = 0; i < 8; ++i) mx = __builtin_elementwise_max(mx, __builtin_elementwise_abs(vb[i] * gbv[i])); } } }
#pragma unroll
        for (int sh = 8; sh < 64; sh <<= 1) {
#pragma unroll
            for (int e = 0; e < 4; ++e) mx[e] = fmaxf(mx[e], __shfl_xor(mx[e], sh)); }
        if (lane < 8) { LAS float* o = cmw + wave * 32 + 4 * c4; o[0] = mx[0]; o[1] = mx[1]; o[2] = mx[2]; o[3] = mx[3]; }
        __syncthreads();
        if (tid < 32) { float m = cmw[tid];
#pragma unroll
            for (int w = 1; w < 8; ++w) m = fmaxf(m, cmw[w * 32 + tid]);
            cmf[tid] = m; ((GAS unsigned*)cmax)[(size_t)b * ostride + drow0 + tid] = __float_as_uint(m); }
        __syncthreads();
        float inv[4];
#pragma unroll
        for (int j = 0; j < 4; ++j) { const float cm = cmf[rr + 8 * j]; inv[j] = cm > 0.f ? 127.0f / cm : 0.f; }
        { f32x4 cur[8], nxt[8]; float gc[8], gn[8];
          int kb = wave;
          if (kb < kblk) I8F_LOAD(cur, gc, kb);
#pragma nounroll
          while (kb < kblk) {
              const int kbn = kb + 8;
              if (kbn < kblk) I8F_LOAD(nxt, gn, kbn);
#pragma unroll
              for (int i = 0; i < 8; ++i) { LAS float* sp = scr + (8 * i + rr) * 33 + 4 * c4; const f32x4 v = cur[i] * gc[i]; sp[0] = v[0]; sp[1] = v[1]; sp[2] = v[2]; sp[3] = v[3]; }
              asm volatile("s_waitcnt lgkmcnt(0)" ::: "memory");
              unsigned char* wt = WTb + (size_t)b * wt_bstride;
#pragma unroll
              for (int j = 0; j < 4; ++j) { const int n = rr + 8 * j; const LAS float* sp = scr + (8 * c4) * 33 + n;
                  *(GAS u32x2*)(wt + (size_t)(drow0 + n) * K + 64 * kb + 8 * c4) = (u32x2){pg8::pack_i8x4(sp[0 * 33], sp[1 * 33], sp[2 * 33], sp[3 * 33], inv[j]), pg8::pack_i8x4(sp[4 * 33], sp[5 * 33], sp[6 * 33], sp[7 * 33], inv[j])}; }
              asm volatile("s_waitcnt lgkmcnt(0)" ::: "memory");
#pragma unroll
              for (int i = 0; i < 8; ++i) { cur[i] = nxt[i]; gc[i] = gn[i]; }
              kb = kbn; } }
#undef I8F_LOAD
    }
}
__device__ __forceinline__ void wq_rows(const bf16* src, unsigned char* dst, const unsigned* rowmax, int gw, int NGW, int lane) {
    for (int r = gw; r < POOLW; r += NGW) {
        const float cm = __uint_as_float(__hip_atomic_load((const GAS unsigned*)rowmax + r, __ATOMIC_RELAXED, __HIP_MEMORY_SCOPE_AGENT)), inv = cm > 0.f ? 127.0f / cm : 0.f;
        const GAS u32x4* s = (const GAS u32x4*)(src + (size_t)r * D) + lane; GAS u32x2* d = (GAS u32x2*)(dst + (size_t)r * D) + lane;
        u32x4 v[8];
#pragma unroll
        for (int i = 0; i < 8; ++i) v[i] = s[64 * i];
#pragma unroll
        for (int i = 0; i < 8; ++i) d[64 * i] = (u32x2){pg8::pack_i8x4(bf_lo(v[i].x), bf_hi(v[i].x), bf_lo(v[i].y), bf_hi(v[i].y), inv), pg8::pack_i8x4(bf_lo(v[i].z), bf_hi(v[i].z), bf_lo(v[i].w), bf_hi(v[i].w), inv)};
    }
}
__device__ __forceinline__ void xg_rows(const float* x, bf16* out, pg8::rss_t* rss, unsigned char* q8out, int gw, int NGW, int lane) {
    for (int m = gw; m < S; m += NGW) {
        const GAS f32x4* xr = (const GAS f32x4*)(x + (size_t)m * D) + lane;
        f32x4 v[16]; float s = 0.f;
        GAS u32x2* o8 = (GAS u32x2*)(out + (size_t)m * D) + lane;
#pragma unroll
        for (int j = 0; j < 16; ++j) v[j] = xr[64 * j];
#pragma unroll
        for (int j = 0; j < 16; ++j) { u32x2 w; w.x = cvt_pk_bf16(v[j][0], v[j][1]); w.y = cvt_pk_bf16(v[j][2], v[j][3]); o8[64 * j] = w;
            const float a0 = bf_lo(w.x), a1 = bf_hi(w.x), a2 = bf_lo(w.y), a3 = bf_hi(w.y); s += (a0 * a0 + a1 * a1) + (a2 * a2 + a3 * a3); }
        const float tot = wave_sum(s); const pg8::rss_t fx = pg8::rss_fix(tot); if (lane == 0) rss[m] = fx;
        if (q8out) {
            const float qinv = 1.0f / (sqrtf((float)fx * (1.0f / 16777216.0f / 4096.0f)) * (pg8::I8_CLIP / 127.0f) + 1e-20f);
            GAS unsigned* q = (GAS unsigned*)(q8out + (size_t)m * D) + lane;
#pragma unroll
            for (int j = 0; j < 16; ++j) { const unsigned w0 = cvt_pk_bf16(v[j][0], v[j][1]), w1 = cvt_pk_bf16(v[j][2], v[j][3]); q[64 * j] = pg8::pack_i8x4(bf_lo(w0), bf_hi(w0), bf_lo(w1), bf_hi(w1), qinv); } }
    }
}

__device__ __forceinline__ void acc8(float (&s)[8], const u32x4 q, const float w) {
    s[0] += w * bf_lo(q.x); s[1] += w * bf_hi(q.x); s[2] += w * bf_lo(q.y); s[3] += w * bf_hi(q.y); s[4] += w * bf_lo(q.z); s[5] += w * bf_hi(q.z); s[6] += w * bf_lo(q.w); s[7] += w * bf_hi(q.w);
}
__device__ __forceinline__ void poolgate_phase(const bf16* Y, const bf16* Z, const float* scale, bf16* G2, int vcu, int G, int tid) {
    constexpr int CH = 128;
    const int nunits = (S / CH) * 2;
    for (int u = vcu; u < nunits; u += G) {
        const int cb = u & 1, tc = u >> 1, t0 = tc * CH, c0 = cb * 4096 + tid * 8;
        const int j = c0 >> 11, w = 2 << j, left = (w - 1) >> 1, right = w - 1 - left;
        const bf16* yp = Y + c0; const bf16* zp = Z + c0; bf16* gp = G2 + c0;
        const f32x4 sc0 = *(const GAS f32x4*)(scale + c0), sc1 = *(const GAS f32x4*)(scale + c0 + 4);
        float sum[8];
#pragma unroll
        for (int e = 0; e < 8; ++e) sum[e] = 0.f;
        for (int s = t0 - left; s <= t0 + right; ++s) { const int sc = s < 0 ? 0 : (s >= S ? S - 1 : s); const float ws = (s >= 0 && s < S) ? 1.f : 0.f;
            acc8(sum, *(const GAS u32x4*)(yp + (size_t)sc * POOLW), ws); }
        for (int i0 = 0; i0 < CH; i0 += 8) {
            u32x4 cc[8], zz[8], qa[8], qd[8];
#pragma unroll
            for (int i = 0; i < 8; ++i) { const int t = t0 + i0 + i, sa = t + 1 + right, sd = t - left, sac = sa < S ? sa : S - 1, sdc = sd > 0 ? sd : 0;
                cc[i] = *(const GAS u32x4*)(yp + (size_t)t * POOLW); zz[i] = *(const GAS u32x4*)(zp + (size_t)t * POOLW);
                qa[i] = *(const GAS u32x4*)(yp + (size_t)sac * POOLW); qd[i] = *(const GAS u32x4*)(yp + (size_t)sdc * POOLW); }
#pragma unroll
            for (int i = 0; i < 8; ++i) { const int t = t0 + i0 + i, sa = t + 1 + right, sd = t - left;
                const int lo = (t - left) > 0 ? (t - left) : 0, hi = (t + right + 1) < S ? (t + right + 1) : S;
                const float inv = 1.0f / (float)(hi - lo);
                const u32x4 c = cc[i], z = zz[i];
                u32x4 o;
                o.x = cvt_pk_bf16((sum[0] * inv - bf_lo(c.x)) * sc0[0] * siluf_(bf_lo(z.x)), (sum[1] * inv - bf_hi(c.x)) * sc0[1] * siluf_(bf_hi(z.x)));
                o.y = cvt_pk_bf16((sum[2] * inv - bf_lo(c.y)) * sc0[2] * siluf_(bf_lo(z.y)), (sum[3] * inv - bf_hi(c.y)) * sc0[3] * siluf_(bf_hi(z.y)));
                o.z = cvt_pk_bf16((sum[4] * inv - bf_lo(c.z)) * sc1[0] * siluf_(bf_lo(z.z)), (sum[5] * inv - bf_hi(c.z)) * sc1[1] * siluf_(bf_hi(z.z)));
                o.w = cvt_pk_bf16((sum[6] * inv - bf_lo(c.w)) * sc1[2] * siluf_(bf_lo(z.w)), (sum[7] * inv - bf_hi(c.w)) * sc1[3] * siluf_(bf_hi(z.w)));
                *(GAS u32x4*)(gp + (size_t)t * POOLW) = o;
                acc8(sum, qa[i], sa < S ? 1.f : 0.f); acc8(sum, qd[i], sd >= 0 ? -1.f : 0.f); }
        }
    }
}

namespace att {
constexpr int KROW = 136, VROW = 68, OROW = 136;
constexpr int KT_BYTES = 64 * KROW * 2, VT_BYTES = 128 * VROW * 2, STAGE = KT_BYTES + VT_BYTES;
constexpr int O_OFF = 2 * STAGE, O_BYTES = 32 * OROW * 2;
constexpr int G_OFF = O_OFF + 8 * O_BYTES;
constexpr int ATT_LDS = G_OFF + 1024;
struct KV { u32x4 k0, k1, v0, v1; };
__device__ __forceinline__ void kv_load(KV& r, const bf16* Kg, const bf16* VT, int kvh, int s0, int tid) {
    asm volatile("" : "+v"(tid));
    const int key = tid >> 3, ch = tid & 7;
    const bf16* kp = Kg + (size_t)(s0 + key) * KVW + kvh * HD + ch * 16;
    r.k0 = *(const GAS u32x4*)kp; r.k1 = *(const GAS u32x4*)(kp + 8);
    r.v0 = *(const GAS u32x4*)(VT + (size_t)(kvh * HD + key) * S + s0 + ch * 8);
    r.v1 = *(const GAS u32x4*)(VT + (size_t)(kvh * HD + key + 64) * S + s0 + ch * 8);
}
__device__ __forceinline__ void kv_store(const KV& r, LAS unsigned char* stage, const LAS float* kgl, int tid) {
    asm volatile("" : "+v"(tid));
    const int key = tid >> 3, ch = tid & 7;
    LAS bf16* Kl = (LAS bf16*)stage; LAS bf16* Vl = (LAS bf16*)(stage + KT_BYTES);
    const u32x4 a = r.k0, b = r.k1;
    float v[16] = {bf_lo(a.x), bf_hi(a.x), bf_lo(a.y), bf_hi(a.y), bf_lo(a.z), bf_hi(a.z), bf_lo(a.w), bf_hi(a.w), bf_lo(b.x), bf_hi(b.x), bf_lo(b.y), bf_hi(b.y), bf_lo(b.z), bf_hi(b.z), bf_lo(b.w), bf_hi(b.w)};
    float ss = 0.f;
#pragma unroll
    for (int e = 0; e < 16; ++e) ss += v[e] * v[e];
    ss += __shfl_xor(ss, 1); ss += __shfl_xor(ss, 2); ss += __shfl_xor(ss, 4);
    const float rs = 1.0f / sqrtf(ss * (1.0f / HD) + EPS);
    const LAS f32x4* kg = (const LAS f32x4*)(kgl + ch * 16);
    const f32x4 g0 = kg[0], g1 = kg[1], g2 = kg[2], g3 = kg[3];
    u32x4 w0, w1;
    w0.x = cvt_pk_bf16(v[0] * rs * g0[0], v[1] * rs * g0[1]); w0.y = cvt_pk_bf16(v[2] * rs * g0[2], v[3] * rs * g0[3]); w0.z = cvt_pk_bf16(v[4] * rs * g1[0], v[5] * rs * g1[1]); w0.w = cvt_pk_bf16(v[6] * rs * g1[2], v[7] * rs * g1[3]);
    w1.x = cvt_pk_bf16(v[8] * rs * g2[0], v[9] * rs * g2[1]); w1.y = cvt_pk_bf16(v[10] * rs * g2[2], v[11] * rs * g2[3]); w1.z = cvt_pk_bf16(v[12] * rs * g3[0], v[13] * rs * g3[1]); w1.w = cvt_pk_bf16(v[14] * rs * g3[2], v[15] * rs * g3[3]);
    *(LAS u32x4*)(Kl + key * KROW + ch * 16) = w0; *(LAS u32x4*)(Kl + key * KROW + ch * 16 + 8) = w1;
    *(LAS u32x2*)(Vl + key * VROW + ch * 8) = (u32x2){r.v0.x, r.v0.y}; *(LAS u32x2*)(Vl + key * VROW + ch * 8 + 4) = (u32x2){r.v0.z, r.v0.w};
    *(LAS u32x2*)(Vl + (key + 64) * VROW + ch * 8) = (u32x2){r.v1.x, r.v1.y}; *(LAS u32x2*)(Vl + (key + 64) * VROW + ch * 8 + 4) = (u32x2){r.v1.z, r.v1.w};
}
__device__ __forceinline__ void unit_of(int u, int& kvh, int& qb) { kvh = (u >> 3) & 7; qb = ((u >> 6) << 3) + (u & 7); }
__device__ __forceinline__ void attn_phase(LAS unsigned char* lds, const bf16* Q, bf16* Gout, const bf16* Kg, const bf16* VT, const bf16* Z,
                                           const float* qgain, const float* kgain, const float* sink, int vcu, int G, int tid0) {
    int tid = tid0; const int wave = __builtin_amdgcn_readfirstlane(tid >> 6);
    int lane = tid & 63, lr = lane & 31, hh = lane >> 5;
    LAS float* gl = (LAS float*)(lds + G_OFF);
    LAS bf16* Ol = (LAS bf16*)(lds + O_OFF + wave * O_BYTES);
    if (tid < 128) gl[tid] = qgain[tid]; else if (tid < 256) gl[tid] = kgain[tid - 128];
    const int upw = (2048 + G - 1) / G;
    const int u_first = vcu * upw;
    u32x4 qraw[8]; KV kv;
    if (u_first < 2048) { int kvh, qb; unit_of(u_first, kvh, qb); const int t0 = qb * 64, c_lo = (2 - qb) > 0 ? (2 - qb) : 0;
        const bf16* qrow = Q + (size_t)(t0 + 32 * (wave & 1) + lr) * QW + (kvh * 4 + (wave >> 1)) * HD + 8 * hh;
#pragma unroll
        for (int j = 0; j < 8; ++j) qraw[j] = *(const GAS u32x4*)(qrow + 16 * j);
        kv_load(kv, Kg, VT, kvh, t0 - 128 + 64 * c_lo, tid); }
    __syncthreads();
    for (int ui = 0; ui < upw; ++ui) {
        const int u = u_first + ui; if (u >= 2048) break;
        asm volatile("" : "+v"(tid)); lane = tid & 63; lr = lane & 31; hh = lane >> 5;
        int kvh, qb; unit_of(u, kvh, qb);
        const int t0 = qb * 64, hq = kvh * 4 + (wave >> 1), tq = t0 + 32 * (wave & 1) + lr;
        const int c_lo = (2 - qb) > 0 ? (2 - qb) : 0, c_hi = (257 - qb) < 4 ? (257 - qb) : 4;
        const float slope2 = fast_exp2(-0.25f * (float)(hq + 1)) * LOG2E, sink2 = sink[hq] * LOG2E;
        bf16x8 qf[8];
        { float ss = 0.f;
#pragma unroll
          for (int j = 0; j < 8; ++j) { const float a0 = bf_lo(qraw[j].x), a1 = bf_hi(qraw[j].x), a2 = bf_lo(qraw[j].y), a3 = bf_hi(qraw[j].y), a4 = bf_lo(qraw[j].z), a5 = bf_hi(qraw[j].z), a6 = bf_lo(qraw[j].w), a7 = bf_hi(qraw[j].w);
              ss += (a0 * a0 + a1 * a1) + (a2 * a2 + a3 * a3) + (a4 * a4 + a5 * a5) + (a6 * a6 + a7 * a7); }
          ss += __shfl_xor(ss, 32);
          const float rs = (1.0f / sqrtf(ss * (1.0f / HD) + EPS)) * (0.08838834764831845f * LOG2E);
#pragma unroll
          for (int j = 0; j < 8; ++j) { const f32x4 g0 = *(const LAS f32x4*)(gl + 16 * j + 8 * hh), g1 = *(const LAS f32x4*)(gl + 16 * j + 8 * hh + 4);
              u32x4 w;
              w.x = cvt_pk_bf16(bf_lo(qraw[j].x) * rs * g0[0], bf_hi(qraw[j].x) * rs * g0[1]); w.y = cvt_pk_bf16(bf_lo(qraw[j].y) * rs * g0[2], bf_hi(qraw[j].y) * rs * g0[3]);
              w.z = cvt_pk_bf16(bf_lo(qraw[j].z) * rs * g1[0], bf_hi(qraw[j].z) * rs * g1[1]); w.w = cvt_pk_bf16(bf_lo(qraw[j].w) * rs * g1[2], bf_hi(qraw[j].w) * rs * g1[3]);
              qf[j] = __builtin_bit_cast(bf16x8, w); }
        }
        kv_store(kv, lds, gl + 128, tid);
        __syncthreads();
        float mrun = sink2, lrun = (hh == 0) ? 1.0f : 0.0f;
        f32x16 ot[4];
#pragma unroll
        for (int dt = 0; dt < 4; ++dt)
#pragma unroll
            for (int r = 0; r < 16; ++r) ot[dt][r] = 0.f;
        for (int c = c_lo; c <= c_hi; ++c) {
            const int s0 = t0 - 128 + 64 * c, st_i = (c - c_lo) & 1;
            asm volatile("" : "+v"(lr), "+v"(hh));
            if (c < c_hi) kv_load(kv, Kg, VT, kvh, s0 + 64, tid);
            const LAS bf16* Kl = (const LAS bf16*)(lds + st_i * STAGE); const LAS bf16* Vl = (const LAS bf16*)(lds + st_i * STAGE + KT_BYTES);
            f32x16 st[2];
#pragma unroll
            for (int kt = 0; kt < 2; ++kt) {
#pragma unroll
                for (int r = 0; r < 16; ++r) st[kt][r] = 0.f;
#pragma unroll
                for (int j = 0; j < 8; ++j) { const bf16x8 kf = *(const LAS bf16x8*)(Kl + (32 * kt + lr) * KROW + 16 * j + 8 * hh);
                    st[kt] = __builtin_amdgcn_mfma_f32_32x32x16_f16(kf, qf[j], st[kt], 0, 0, 0); } }
            const float fb = (float)(s0 + 4 * hh - tq);
            float mx = -INFINITY;
#pragma unroll
            for (int kt = 0; kt < 2; ++kt)
#pragma unroll
                for (int r = 0; r < 16; ++r) { const float ax = fabsf(fb + (float)(32 * kt + 8 * (r >> 2) + (r & 3)));
                    float v = st[kt][r] - slope2 * ax; v = (ax > 128.0f) ? -INFINITY : v; st[kt][r] = v; mx = fmaxf(mx, v); }
            mx = fmaxf(mx, __shfl_xor(mx, 32));
            const float mnew = fmaxf(mrun, mx), alpha = fast_exp2(mrun - mnew);
            mrun = mnew; lrun *= alpha;
#pragma unroll
            for (int dt = 0; dt < 4; ++dt)
#pragma unroll
                for (int r = 0; r < 16; ++r) ot[dt][r] *= alpha;
            bf16x8 pk[2][2];
#pragma unroll
            for (int kt = 0; kt < 2; ++kt)
#pragma unroll
                for (int jj = 0; jj < 2; ++jj) { float p[8];
#pragma unroll
                    for (int e = 0; e < 8; ++e) { p[e] = fast_exp2(st[kt][8 * jj + e] - mnew); lrun += p[e]; }
                    u32x4 w; w.x = cvt_pk_bf16(p[0], p[1]); w.y = cvt_pk_bf16(p[2], p[3]); w.z = cvt_pk_bf16(p[4], p[5]); w.w = cvt_pk_bf16(p[6], p[7]);
                    pk[kt][jj] = __builtin_bit_cast(bf16x8, w); }
#pragma unroll
            for (int kt = 0; kt < 2; ++kt)
#pragma unroll
                for (int jj = 0; jj < 2; ++jj)
#pragma unroll
                    for (int dt = 0; dt < 4; ++dt) { const LAS bf16* vp = Vl + (32 * dt + lr) * VROW + 32 * kt + 16 * jj + 4 * hh;
                        const u32x2 a0 = *(const LAS u32x2*)vp, a1 = *(const LAS u32x2*)(vp + 8);
                        const bf16x8 vf = __builtin_bit_cast(bf16x8, (u32x4){a0.x, a0.y, a1.x, a1.y});
                        ot[dt] = __builtin_amdgcn_mfma_f32_32x32x16_f16(vf, pk[kt][jj], ot[dt], 0, 0, 0); }
            if (c < c_hi) kv_store(kv, lds + (st_i ^ 1) * STAGE, gl + 128, tid);
            __syncthreads();
        }
        if (ui + 1 < upw && u + 1 < 2048) {
            int kvh2, qb2; unit_of(u + 1, kvh2, qb2); const int t02 = qb2 * 64, c_lo2 = (2 - qb2) > 0 ? (2 - qb2) : 0;
            const bf16* qrow = Q + (size_t)(t02 + 32 * (wave & 1) + lr) * QW + (kvh2 * 4 + (wave >> 1)) * HD + 8 * hh;
#pragma unroll
            for (int j = 0; j < 8; ++j) qraw[j] = *(const GAS u32x4*)(qrow + 16 * j);
            kv_load(kv, Kg, VT, kvh2, t02 - 128 + 64 * c_lo2, tid); }
        lrun += __shfl_xor(lrun, 32);
        const float inv = 1.0f / lrun;
#pragma unroll
        for (int dt = 0; dt < 4; ++dt)
#pragma unroll
            for (int g4 = 0; g4 < 4; ++g4) { u32x2 w; w.x = cvt_pk_bf16(ot[dt][4 * g4 + 0] * inv, ot[dt][4 * g4 + 1] * inv); w.y = cvt_pk_bf16(ot[dt][4 * g4 + 2] * inv, ot[dt][4 * g4 + 3] * inv);
                *(LAS u32x2*)(Ol + lr * OROW + 32 * dt + 8 * g4 + 4 * hh) = w; }
        asm volatile("s_waitcnt lgkmcnt(0)" ::: "memory");
        { const int rsub = lane >> 4, chunk = lane & 15; const size_t gbase = (size_t)(t0 + 32 * (wave & 1)) * QW + hq * HD + 8 * chunk;
          u32x4 zz[8];
#pragma unroll
          for (int i = 0; i < 8; ++i) zz[i] = *(const GAS u32x4*)(Z + gbase + (size_t)(4 * i + rsub) * QW);
#pragma unroll
          for (int i = 0; i < 8; ++i) { const u32x4 o = *(const LAS u32x4*)(Ol + (4 * i + rsub) * OROW + 8 * chunk); const u32x4 z = zz[i];
              u32x4 w;
              w.x = cvt_pk_bf16(bf_lo(o.x) * siluf_(bf_lo(z.x)), bf_hi(o.x) * siluf_(bf_hi(z.x))); w.y = cvt_pk_bf16(bf_lo(o.y) * siluf_(bf_lo(z.y)), bf_hi(o.y) * siluf_(bf_hi(z.y)));
              w.z = cvt_pk_bf16(bf_lo(o.z) * siluf_(bf_lo(z.z)), bf_hi(o.z) * siluf_(bf_hi(z.z))); w.w = cvt_pk_bf16(bf_lo(o.w) * siluf_(bf_lo(z.w)), bf_hi(o.w) * siluf_(bf_hi(z.w)));
              *(GAS u32x4*)(Gout + gbase + (size_t)(4 * i + rsub) * QW) = w; } }
    }
    __syncthreads();
}
}

struct Args { const float* in[15]; float* out; unsigned char* ws; int ph_lo, ph_hi; };
constexpr int N_PHASES = 1 + DEPTH * 7;

__global__ void __launch_bounds__(512, 2) fwd_kernel(Args args) {
    extern __shared__ __attribute__((aligned(16))) unsigned char lds_raw[];
    LAS unsigned char* lds = (LAS unsigned char*)lds_raw;
    volatile LAS unsigned* MISC = (volatile LAS unsigned*)(lds + MISC_OFF);
    const int tid = threadIdx.x, wave = __builtin_amdgcn_readfirstlane(tid >> 6);
    const int G = gridDim.x, bx = blockIdx.x;
    unsigned* ctl = (unsigned*)(args.ws + WS_CTL);
    for (int u = tid; u < (LDS_BYTES - LDSCTL_OFF) / 4; u += 512) ((LAS unsigned*)(lds + LDSCTL_OFF))[u] = 0u;
    __syncthreads();
    const int lo = args.ph_lo, hi = args.ph_hi;
    XcdBarrier bar; bar.bar = ctl + CW_BAR; bar.x = 0; bar.st = MISC + 8; bar.wave = wave;
    if (hi - lo > 1) bar = xcd_barrier_post(ctl + CW_BAR, MISC + 8, wave);
#define IN(k) (lo <= (k) && (k) < hi)
#define BOTH(k) (IN(k) && IN((k) + 1))
#define GRID_BAR(k) do { if (BOTH(k)) { XcdBarrier b2 = bar; LAUNDER_S(b2.bar); xcd_barrier(b2); } } while (0)

#define LAUNDER_S(x) asm volatile("" : "+s"(x))
#define LAUNDER_V(x) asm volatile("" : "+v"(x))
#define PHASE_BASES() unsigned char* wsp = args.ws; LAUNDER_S(wsp); int Gp = G, bxp = bx; LAUNDER_S(Gp); LAUNDER_S(bxp); int tidp = wave * 64 + lane_id(); LAUNDER_V(tidp); \
        const int lanep = tidp & 63, wavep = __builtin_amdgcn_readfirstlane(tidp >> 6); \
        const int vcu = (Gp % 8 == 0) ? (bxp % 8) * (Gp / 8) + bxp / 8 : bxp; const int gw = vcu * 8 + wavep, NGW = Gp * 8; (void)gw; (void)NGW; (void)wsp; (void)lanep

    if (IN(0)) {
        PHASE_BASES();
        LAS float* scr = (LAS float*)(lds + wavep * 16384);
        REPEAT(PROBE_PRO) {
        if ((I8_AIN_MASK & 0x3) != 0x3) {
#pragma nounroll
            for (int b = 0; b < 2; ++b) if (!((launder_i(I8_AIN_MASK) >> b) & 1))
                transpose_batch(args.in[3] + (size_t)b * D * AIN, 1, D, AIN, (bf16*)(wsp + WS_WAIN) + (size_t)b * D * AIN, 1, scr, gw, NGW, lanep, 0, -1, args.in[2] + (size_t)b * 2 * D, 2 * D); }
        transpose_batch(args.in[7], 2, QW, D, (bf16*)(wsp + WS_WAOUT), 0, scr, gw, NGW, lanep);
        if ((I8_PIN_MASK & 0x3) != 0x3) {
#pragma nounroll
            for (int b = 0; b < 2; ++b) if (!((launder_i(I8_PIN_MASK) >> b) & 1))
                transpose_batch(args.in[8] + (size_t)b * D * 2 * POOLW, 1, D, 2 * POOLW, (bf16*)(wsp + WS_WPIN) + (size_t)b * D * 2 * POOLW, 0, scr, gw, NGW, lanep, POOLW / 32, POOLW / 32, args.in[2] + D + (size_t)b * 2 * D, 2 * D); }
        {
          const GAS float* src = (const GAS float*)args.in[8]; bf16* dstb = (bf16*)(wsp + WS_WINV);
          for (int row = gw; row < 2 * D; row += NGW) { const int Lx = row / D, k = row - Lx * D;
              const float gg = args.in[2][(size_t)(2 * Lx + 1) * D + k]; const GAS f32x4* sp = (const GAS f32x4*)(src + (size_t)row * (2 * POOLW)) + lanep;
#pragma unroll
              for (int jj = 0; jj < 4; ++jj) { f32x4 v[8];
#pragma unroll
                  for (int i = 0; i < 8; ++i) v[i] = sp[(jj * 8 + i) * 64];
                  GAS u32x2* dp = (GAS u32x2*)(dstb + (((size_t)Lx * 4 + jj) * D + k) * GW) + lanep;
#pragma unroll
                  for (int i = 0; i < 8; ++i) { u32x2 w; w.x = cvt_pk_bf16(v[i][0] * gg, v[i][1] * gg); w.y = cvt_pk_bf16(v[i][2] * gg, v[i][3] * gg); dp[i * 64] = w; } } } }
        transpose_batch(args.in[9], 8, GW, GW, (bf16*)(wsp + WS_WGRP), 0, scr, gw, NGW, lanep);
        transpose_batch(args.in[11], 2, POOLW, D, (bf16*)(wsp + WS_WPOUT), 0, scr, gw, NGW, lanep);
        if ((I8_GATE_MASK & 0xF) != 0xF) {
#pragma nounroll
            for (int b = 0; b < 4; ++b) if (!((launder_i(I8_GATE_MASK) >> b) & 1))
                transpose_batch(args.in[13] + (size_t)b * D * D, 1, D, D, (bf16*)(wsp + WS_WGATE) + (size_t)b * D * D, 0, scr, gw, NGW, lanep, 0, -1, args.in[12] + (size_t)b * D, D, (FP8_GATE_MASK >> b) & 1u); }
        if (I8_GATE_MASK) { __syncthreads(); i8w_fused(args.in[13], 4, I8_GATE_MASK, D, D, 0, D / 32, 0, args.in[12], D, wsp + WS_WGATE, (size_t)D * D * 2, (unsigned*)(wsp + WS_CTL + CTL_CMAX), D, lds, vcu, Gp, tidp); }
        if (I8_AIN_MASK) { __syncthreads(); i8w_fused(args.in[3], 2, I8_AIN_MASK, D, AIN, 0, AIN / 32, 1, args.in[2], 2 * D, wsp + WS_WAIN, (size_t)D * AIN * 2, (unsigned*)(wsp + WS_CTL + CTL_CMAXA), AIN, lds, vcu, Gp, tidp, 128); }
        if (I8_PIN_MASK) { __syncthreads(); i8w_fused(args.in[8], 2, I8_PIN_MASK, D, 2 * POOLW, POOLW / 32, POOLW / 32, 0, args.in[2] + D, 2 * D, wsp + WS_WPIN, (size_t)D * 2 * POOLW * 2, (unsigned*)(wsp + WS_CTL + CTL_CMAXP), 2 * POOLW, lds, vcu, Gp, tidp); __syncthreads(); }
        transpose_batch(args.in[14], 4, PLE, D, (bf16*)(wsp + WS_WPROJ), 0, scr, gw, NGW, lanep);
        {
          constexpr int n4 = DEPTH * S * PLE / 4; const GAS f32x4* src = (const GAS f32x4*)args.in[1]; GAS u32x2* dst = (GAS u32x2*)(wsp + WS_PBF);
          for (int base = gw * 512; base < n4; base += NGW * 512) { f32x4 v[8];
#pragma unroll
              for (int i = 0; i < 8; ++i) v[i] = src[base + i * 64 + lanep];
#pragma unroll
              for (int i = 0; i < 8; ++i) { u32x2 w; w.x = cvt_pk_bf16(v[i][0], v[i][1]); w.y = cvt_pk_bf16(v[i][2], v[i][3]); dst[base + i * 64 + lanep] = w; } } }
        }
        GRID_BAR(0);
    }

    for (int L = 0; L < DEPTH; ++L) {
        const int pb = 1 + L * 7, jl = L >> 1; const bool is_attn = !(L & 1);
        if (IN(pb + 0) && L == 0) {
            PHASE_BASES();
            REPEAT(PROBE_NORM) xg_rows(args.in[0], (bf16*)(wsp + WS_H), (pg8::rss_t*)(wsp + WS_CTL + CTL_RSS), (I8_AIN_MASK & 1) ? (unsigned char*)(wsp + WS_ACT + ACT_XI8) : (unsigned char*)nullptr, gw, NGW, lanep);
            {
                constexpr int off0 = (I8_PIN_MASK & 1) ? POOLW : 0, off1 = (I8_PIN_MASK & 2) ? POOLW : 0;
                bf16* WP = (bf16*)(wsp + WS_WPIN) + (size_t)off0 * D;
                pg8::Gemm g2{(const bf16*)(wsp + WS_WGRP), (const bf16*)(wsp + WS_WINV), GW, GW, 2 * 4 * GW, D, GW, 0, 0, 3, D * GW};
                pg8::StaticOrder so2; so2.init(2 * 4 * GW, D, Gp, bxp);
                pg8::EpiSplit E2{WP, WP, WP, D, D, D, 1 << 30, 1 << 30, 5, (POOLW + off1 - off0) * D, nullptr, 0, I8_PANY ? (unsigned*)(wsp + WS_CTL + CTL_CMAXP) : (unsigned*)nullptr, 5, POOLW, nullptr, nullptr};
                pg8::gemm_phase<pg8::EpiSplit>(lds, g2, so2, E2, tidp);
            }
            GRID_BAR(pb + 0);
        }
        if (IN(pb + 1)) {
            PHASE_BASES();
            const bf16* H = (const bf16*)(wsp + WS_H); unsigned char* ACT = wsp + WS_ACT;
            const pg8::rss_t* rssA = (const pg8::rss_t*)(wsp + WS_CTL + CTL_RSS) + (size_t)(2 * L) * S;
            { bf16* PP = (bf16*)(wsp + WS_PP);
              pg8::Gemm g{(bf16*)(wsp + WS_PBF) + (size_t)L * S * PLE, (bf16*)(wsp + WS_WPROJ) + (size_t)L * D * PLE, PLE, PLE, S, D, PLE, 0, 0, 0, 0};
              pg8::StaticOrder so; so.init(S, D, Gp, bxp);
              pg8::EpiSplit E{PP, PP, PP, D, D, D, 1 << 30, 1 << 30, 0, 0, nullptr, 0, nullptr, 0, 0, nullptr, nullptr};
              pg8::gemm_phase<pg8::EpiSplit>(lds, g, so, E, tidp); }
            if (is_attn && I8_AIN_MASK != 0 && ((I8_AIN_MASK >> jl) & 1)) {
                const bf16* XI8 = (const bf16*)(ACT + ACT_XI8); const bf16* W8 = (const bf16*)(wsp + WS_WAIN) + (size_t)jl * AIN * D;
                const unsigned* cmx = (const unsigned*)(wsp + WS_CTL + CTL_CMAXA) + (size_t)jl * AIN;
                const pg8::rss_t* rssQ = (const pg8::rss_t*)(wsp + WS_CTL + CTL_RSS) + (size_t)(L == 0 ? 0 : 2 * L - 1) * S;
                { pg8::Gemm g{XI8, W8, D / 2, D / 2, S, 9216, D / 2, 0, 0, 0, 0}; pg8::StaticOrder so; so.init(S, 9216, Gp, bxp);
                  pg8::EpiSplit E{(bf16*)(ACT + ACT_Q), (bf16*)(ACT + ACT_K), (bf16*)(ACT + ACT_Z), QW, KVW, QW, 16, 20, 0, 0, rssA, 1, nullptr, 0, 0, cmx, rssQ};
                  pg8::gemm_phase<pg8::EpiSplit, true, 2>(lds, g, so, E, tidp); }
                { bf16* AVT = (bf16*)(ACT + ACT_VT);
                  pg8::Gemm g{W8 + (size_t)9216 * (D / 2), XI8, D / 2, D / 2, KVW, S, D / 2, 0, 0, 0, 0}; pg8::StaticOrder so; so.init(KVW, S, Gp, bxp);
                  pg8::EpiSplit E{AVT, AVT, AVT, S, S, S, 1 << 30, 1 << 30, 0, 0, rssA, 2, nullptr, 0, 0, cmx + 9216, rssQ};
                  pg8::gemm_phase<pg8::EpiSplit, true, 2>(lds, g, so, E, tidp); }
            } else if (is_attn) {
                const bf16* W = (const bf16*)(wsp + WS_WAIN) + (size_t)jl * AIN * D;
                { pg8::Gemm g{H, W, D, D, S, 9216, D, 0, 0, 0, 0}; pg8::StaticOrder so; so.init(S, 9216, Gp, bxp);
                  pg8::EpiSplit E{(bf16*)(ACT + ACT_Q), (bf16*)(ACT + ACT_K), (bf16*)(ACT + ACT_Z), QW, KVW, QW, 16, 20, 0, 0, rssA, 1, nullptr, 0, 0, nullptr, nullptr};
                  pg8::gemm_phase<pg8::EpiSplit>(lds, g, so, E, tidp); }
                { bf16* AVT = (bf16*)(ACT + ACT_VT);
                  pg8::Gemm g{W + (size_t)9216 * D, H, D, D, KVW, S, D, 0, 0, 0, 0}; pg8::StaticOrder so; so.init(KVW, S, Gp, bxp);
                  pg8::EpiSplit E{AVT, AVT, AVT, S, S, S, 1 << 30, 1 << 30, 0, 0, rssA, 2, nullptr, 0, 0, nullptr, nullptr};
                  pg8::gemm_phase<pg8::EpiSplit>(lds, g, so, E, tidp); }
            } else if (I8_PINY_MASK != 0 && ((I8_PINY_MASK >> jl) & 1)) {
                bf16* PZ = (bf16*)(ACT + ACT_PZ);
                { const bf16* XI8 = (const bf16*)(ACT + ACT_XI8); const bf16* W8 = (const bf16*)(wsp + WS_WAIN + (size_t)jl * D * AIN * 2 + (size_t)D * AIN);
                  const unsigned* cmx = (const unsigned*)(wsp + WS_CTL + CTL_CMAXP) + (size_t)jl * 2 * POOLW;
                  const pg8::rss_t* rssQ = (const pg8::rss_t*)(wsp + WS_CTL + CTL_RSS) + (size_t)(2 * L - 1) * S;
                  pg8::Gemm g{XI8, W8, D / 2, D / 2, S, POOLW, D / 2, 0, 0, 0, 0}; pg8::StaticOrder so; so.init(S, POOLW, Gp, bxp);
                  pg8::EpiSplit E{(bf16*)(ACT + ACT_V), PZ, PZ, POOLW, POOLW, POOLW, 1 << 30, 1 << 30, 0, 0, rssA, 1, nullptr, 0, 0, cmx, rssQ};
                  pg8::gemm_phase<pg8::EpiSplit, true, 2>(lds, g, so, E, tidp); }
                { const bf16* Wz = (const bf16*)(wsp + WS_WPIN) + (size_t)jl * 2 * POOLW * D + (size_t)POOLW * D;
                  pg8::Gemm g{H, Wz, D, D, S, POOLW, D, 0, 0, 0, 0}; pg8::StaticOrder so; so.init(S, POOLW, Gp, bxp);
                  pg8::EpiSplit E{PZ, PZ, PZ, POOLW, POOLW, POOLW, 1 << 30, 1 << 30, 0, 0, rssA, 1, nullptr, 0, 0, nullptr, nullptr};
                  pg8::gemm_phase<pg8::EpiSplit>(lds, g, so, E, tidp); }
            } else if (I8_PIN_MASK != 0 && ((I8_PIN_MASK >> jl) & 1)) {
                bf16* PZ = (bf16*)(ACT + ACT_PZ);
                const bf16* XI8 = (const bf16*)(ACT + ACT_XI8); const bf16* W8 = (const bf16*)(wsp + WS_WPIN) + (size_t)jl * 2 * POOLW * D;
                const unsigned* cmx = (const unsigned*)(wsp + WS_CTL + CTL_CMAXP) + (size_t)jl * 2 * POOLW;
                const pg8::rss_t* rssQ = (const pg8::rss_t*)(wsp + WS_CTL + CTL_RSS) + (size_t)(2 * L - 1) * S;
                pg8::Gemm g{XI8, W8, D / 2, D / 2, S, 2 * POOLW, D / 2, 0, 0, 0, 0}; pg8::StaticOrder so; so.init(S, 2 * POOLW, Gp, bxp);
                pg8::EpiSplit E{(bf16*)(ACT + ACT_V), PZ, PZ, POOLW, POOLW, POOLW, 32, 1 << 30, 0, 0, rssA, 1, nullptr, 0, 0, cmx, rssQ};
                pg8::gemm_phase<pg8::EpiSplit, true, 2>(lds, g, so, E, tidp);
            } else {
                bf16* PZ = (bf16*)(ACT + ACT_PZ);
                pg8::Gemm g{H, (const bf16*)(wsp + WS_WPIN) + (size_t)jl * 2 * POOLW * D, D, D, S, 2 * POOLW, D, 0, 0, 0, 0}; pg8::StaticOrder so; so.init(S, 2 * POOLW, Gp, bxp);
                pg8::EpiSplit E{(bf16*)(ACT + ACT_V), PZ, PZ, POOLW, POOLW, POOLW, 32, 1 << 30, 0, 0, rssA, 1, nullptr, 0, 0, nullptr, nullptr};
                pg8::gemm_phase<pg8::EpiSplit>(lds, g, so, E, tidp);
            }
            GRID_BAR(pb + 1);
        }
        if (IN(pb + 2)) {
            PHASE_BASES();
            unsigned char* ACT = wsp + WS_ACT;
            if (is_attn) REPEAT(PROBE_ATT) att::attn_phase(lds, (const bf16*)(ACT + ACT_Q), (bf16*)(ACT + ACT_G), (const bf16*)(ACT + ACT_K), (const bf16*)(ACT + ACT_VT), (const bf16*)(ACT + ACT_Z),
                                         args.in[4] + jl * HD, args.in[5] + jl * HD, args.in[6] + jl * 32, vcu, Gp, tidp);
            if (L == 0 && I8_PANY) {
#pragma nounroll
                for (int b = 0; b < 2; ++b) if ((launder_i(I8_PANY) >> b) & 1) { unsigned char* slot = wsp + WS_WPIN + (size_t)b * 2 * POOLW * D * 2; const bool yonly = (launder_i(I8_PINY_MASK) >> b) & 1;
                    wq_rows((const bf16*)(slot + (yonly ? (size_t)0 : (size_t)POOLW * D * 2)), yonly ? wsp + WS_WAIN + (size_t)b * D * AIN * 2 + (size_t)D * AIN : slot, (const unsigned*)(wsp + WS_CTL + CTL_CMAXP) + (size_t)b * 2 * POOLW, gw, NGW, lanep); } }
            if (!is_attn) REPEAT(PROBE_POOL) poolgate_phase((const bf16*)(ACT + ACT_V), (const bf16*)(ACT + ACT_PZ), args.in[10] + (size_t)jl * POOLW, (bf16*)(ACT + ACT_DP), vcu, Gp, tidp);
            GRID_BAR(pb + 2);
        }
        if (IN(pb + 4)) {
            PHASE_BASES();
            unsigned char* ACT = wsp + WS_ACT;
            const int Kc = is_attn ? QW : POOLW;
            pg8::Gemm g{is_attn ? (const bf16*)(ACT + ACT_G) : (const bf16*)(ACT + ACT_DP), is_attn ? (const bf16*)(wsp + WS_WAOUT) + (size_t)jl * D * QW : (const bf16*)(wsp + WS_WPOUT) + (size_t)jl * D * POOLW, Kc, Kc, S, D, Kc, 0, 0, 0, 0};
            pg8::StaticOrder so; so.init(S, D, Gp, bxp);
            pg8::EpiRes E{(const bf16*)(wsp + WS_H), (bf16*)(wsp + WS_H1), (pg8::rss_t*)(wsp + WS_CTL + CTL_RSS) + (size_t)(2 * L + 1) * S, D, (((FP8_GATE_MASK | I8_GATE_MASK) >> L) & 1) ? (unsigned char*)ACT : (unsigned char*)nullptr, ((I8_GATE_MASK >> L) & 1) ? 2 : 1,
                          (const pg8::rss_t*)(wsp + WS_CTL + CTL_RSS) + (size_t)(2 * L) * S};
            pg8::gemm_phase<pg8::EpiRes>(lds, g, so, E, tidp);
            GRID_BAR(pb + 4);
        }
        if (IN(pb + 6)) {
            PHASE_BASES();
            pg8::StaticOrder so; so.init(S, D, Gp, bxp);
            const bool more = (L + 1 < DEPTH); const bool i8 = ((I8_GATE_MASK >> L) & 1) != 0; const bool f8 = !i8 && ((FP8_GATE_MASK >> L) & 1) != 0;
            pg8::EpiGate E{(const bf16*)(wsp + WS_H1), (const bf16*)(wsp + WS_PP), (const pg8::rss_t*)(wsp + WS_CTL + CTL_RSS) + (size_t)(2 * L + 1) * S,
                           more ? (bf16*)(wsp + WS_H) : (bf16*)nullptr, (pg8::rss_t*)(wsp + WS_CTL + CTL_RSS) + (size_t)(more ? 2 * L + 2 : 0) * S, args.out, D, f8 ? (1.0f / 512.0f) : 1.0f,
                           i8 ? (const unsigned*)(wsp + WS_CTL + CTL_CMAX) + (size_t)L * D : (const unsigned*)nullptr, (const pg8::rss_t*)(wsp + WS_CTL + CTL_RSS) + (size_t)(2 * L) * S,
                           (more && (((L & 1) && ((I8_AIN_MASK >> ((L + 1) >> 1)) & 1)) || (!(L & 1) && ((I8_PANY >> (L >> 1)) & 1)))) ? (unsigned char*)(wsp + WS_ACT + ACT_XI8) : (unsigned char*)nullptr};
            if (I8_GATE_MASK != 0 && i8) {
                pg8::Gemm g{(const bf16*)(wsp + WS_ACT), (const bf16*)(wsp + WS_WGATE) + (size_t)L * D * D, D / 2, D / 2, S, D, D / 2, 0, 0, 0, 0};
                pg8::gemm_phase<pg8::EpiGate, true, 2>(lds, g, so, E, tidp);
            }
            if (FP8_GATE_MASK != 0 && f8) {
                pg8::Gemm g{(const bf16*)(wsp + WS_ACT), (const bf16*)(wsp + WS_WGATE) + (size_t)L * D * D, D / 2, D / 2, S, D, D / 2, 0, 0, 0, 0};
                pg8::gemm_phase<pg8::EpiGate, true, 1>(lds, g, so, E, tidp);
            }
            if (((FP8_GATE_MASK | I8_GATE_MASK) & 0xF) != 0xF && !f8 && !i8) {
                pg8::Gemm g{(const bf16*)(wsp + WS_H1), (const bf16*)(wsp + WS_WGATE) + (size_t)L * D * D, D, D, S, D, D, 0, 0, 0, 0};
                pg8::gemm_phase<pg8::EpiGate>(lds, g, so, E, tidp);
            }
            GRID_BAR(pb + 6);
        }
    }
#undef IN
#undef BOTH
#undef GRID_BAR
}

extern "C" void kernel_launch(void* const* d_in, const int* in_sizes, int n_in, void* d_out, int out_size, void* d_ws, size_t ws_size, hipStream_t stream) {
    static int grid = 0;
    if (grid == 0) {
        if (n_in != 15 || in_sizes[0] != S * D || out_size != S * D || ws_size < WS_END) {
            fprintf(stderr, "kernel_launch: unexpected shapes / workspace (n_in %d, in0 %d, out %d, ws %zu, need %zu); nothing launched\n", n_in, n_in > 0 ? in_sizes[0] : -1, out_size, ws_size, (size_t)WS_END); grid = -1; return; }
        int dev = 0, cus = 0, per_cu = 0;
        if (hipGetDevice(&dev) != hipSuccess || hipDeviceGetAttribute(&cus, hipDeviceAttributeMultiprocessorCount, dev) != hipSuccess) { grid = -1; return; }
        if (hipFuncSetAttribute((const void*)fwd_kernel, hipFuncAttributeMaxDynamicSharedMemorySize, LDS_BYTES) != hipSuccess) { fprintf(stderr, "kernel_launch: hipFuncSetAttribute failed\n"); grid = -1; return; }
        if (hipOccupancyMaxActiveBlocksPerMultiprocessor(&per_cu, (const void*)fwd_kernel, 512, LDS_BYTES) != hipSuccess || per_cu < 1)
            fprintf(stderr, "kernel_launch: note: occupancy query reports %d workgroups per CU\n", per_cu);
        (void)hipGetLastError();
        grid = cus;
    }
    if (grid < 0) return;
    if (hipMemsetAsync((char*)d_ws + WS_CTL, 0, CTL_ZERO_BYTES, stream) != hipSuccess) return;
    Args a{};
    for (int i = 0; i < 15; ++i) a.in[i] = (const float*)d_in[i];
    a.out = (float*)d_out; a.ws = (unsigned char*)d_ws;
#if MK_ONE_LAUNCH
    a.ph_lo = 0; a.ph_hi = N_PHASES;
    hipLaunchKernelGGL(fwd_kernel, dim3(grid), dim3(512), LDS_BYTES, stream, a);
#else
    for (int k = 0; k < N_PHASES; ++k) { a.ph_lo = k; a.ph_hi = k + 1; hipLaunchKernelGGL(fwd_kernel, dim3(grid), dim3(512), LDS_BYTES, stream, a); }
#endif
}
```

```cpp
#include <hip/hip_runtime.h>
#include <cstdio>
#include <cstdint>

#define LAS __attribute__((address_space(3)))
#define GAS __attribute__((address_space(1)))
typedef unsigned short bf16;
typedef _Float16 bf16x8 __attribute__((ext_vector_type(8)));
typedef float f32x4 __attribute__((ext_vector_type(4)));
typedef float f32x2 __attribute__((ext_vector_type(2)));
typedef float f32x16 __attribute__((ext_vector_type(16)));
typedef unsigned u32x4 __attribute__((ext_vector_type(4)));
typedef unsigned u32x2 __attribute__((ext_vector_type(2)));
typedef GAS unsigned gu32;

#ifndef PROBE_PRO
#define PROBE_PRO 1
#endif
#ifndef PROBE_NORM
#define PROBE_NORM 1
#endif
#ifndef PROBE_ATT
#define PROBE_ATT 1
#endif
#ifndef PROBE_POOL
#define PROBE_POOL 1
#endif
#define REPEAT(n) _Pragma("nounroll") for (int _rep = 0, _n = launder_i(n); _rep < _n; ++_rep)
#ifndef FP8_GATE_MASK
#define FP8_GATE_MASK 0x0
#endif
#ifndef I8_GATE_MASK
#define I8_GATE_MASK 0xF
#endif
#ifndef I8_AIN_MASK
#define I8_AIN_MASK 0x3
#endif
#ifndef I8_PIN_MASK
#define I8_PIN_MASK 0x3
#endif
#ifndef MK_ONE_LAUNCH
#define MK_ONE_LAUNCH 1
#endif

constexpr int S = 16384, D = 4096, DEPTH = 4;
constexpr int QW = 4096, KVW = 1024, AIN = 10240, NKV = 8, HD = 128;
constexpr int POOLW = 8192, GW = 2048, PLE = 256;
constexpr float EPS = 1e-6f;
constexpr float LOG2E = 1.4426950408889634f;

constexpr size_t MiB = 1u << 20;
constexpr size_t WS_CTL = 0, CTL_ZERO_BYTES = 4 * MiB;
constexpr size_t WS_WAIN = 6 * MiB;
constexpr size_t WS_WAOUT = WS_WAIN + 160 * MiB;
constexpr size_t WS_WPIN = WS_WAOUT + 64 * MiB;
constexpr size_t WS_WGRP = WS_WPIN + 256 * MiB;
constexpr size_t WS_WPOUT = WS_WGRP + 64 * MiB;
constexpr size_t WS_WGATE = WS_WPOUT + 128 * MiB;
constexpr size_t WS_WPROJ = WS_WGATE + 128 * MiB;
constexpr size_t WS_PBF = WS_WPROJ + 8 * MiB;
constexpr size_t WS_H = WS_PBF + 32 * MiB;
constexpr size_t WS_H1 = WS_H + 128 * MiB;
constexpr size_t WS_PP = WS_H1 + 128 * MiB;
constexpr size_t WS_ACT = WS_PP + 128 * MiB;
constexpr size_t WS_END = WS_ACT + 768 * MiB;
constexpr size_t WS_WINV = WS_ACT + 512 * MiB;
constexpr size_t ACT_XI8 = 704 * MiB;
constexpr size_t ACT_Q = 0, ACT_K = 128 * MiB, ACT_Z = 160 * MiB, ACT_VT = 288 * MiB, ACT_G = 320 * MiB;
constexpr size_t ACT_V = 0, ACT_PZ = 256 * MiB, ACT_DP = 512 * MiB;

constexpr int CW_BAR = 4096;
constexpr size_t CTL_CMAXP = 2048 * 1024;
constexpr size_t CTL_CMAXA = 1856 * 1024;
constexpr size_t CTL_CMAX = 1792 * 1024;
constexpr size_t CTL_RSS = 512 * 1024;

constexpr int RING_BYTES = 131072;
constexpr int LDS_BYTES = 147456;
constexpr int LDSCTL_OFF = LDS_BYTES - 1024, MISC_OFF = LDSCTL_OFF + 320;

typedef _Float16 half2v __attribute__((ext_vector_type(2)));
__device__ __forceinline__ unsigned cvt_pk_bf16(float lo, float hi) { return __builtin_bit_cast(unsigned, __builtin_convertvector((f32x2){lo, hi}, half2v)); }
__device__ __forceinline__ float bf_lo(unsigned w) { return (float)__builtin_bit_cast(_Float16, (unsigned short)(w & 0xffffu)); }
__device__ __forceinline__ float bf_hi(unsigned w) { return (float)__builtin_bit_cast(_Float16, (unsigned short)(w >> 16)); }
__device__ __forceinline__ float fast_exp2(float x) { return __builtin_amdgcn_exp2f(x); }
__device__ __forceinline__ float fast_rcp(float x) { return __builtin_amdgcn_rcpf(x); }
__device__ __forceinline__ float sigmoidf_(float a) { return fast_rcp(1.0f + fast_exp2(-a * LOG2E)); }
__device__ __forceinline__ float siluf_(float a) { return a * sigmoidf_(a); }
__device__ __forceinline__ int launder_i(int n) { asm volatile("" : "+s"(n)); return n; }
__device__ __forceinline__ float wave_sum(float v) {
#pragma unroll
    for (int o = 1; o < 64; o <<= 1) v += __shfl_xor(v, o);
    return v;
}

__device__ __forceinline__ int lane_id();
namespace pg8 {
typedef unsigned short bf16_t;
constexpr int BM = 256, BK = 64, HALF = 128, HTB = HALF * BK * 2, STAGE_BYTES = 8 * HTB, NXCD = 8, WGM = 8;
__host__ __device__ __forceinline__ int lds_byte(int r, int c) { const int st = (r >> 4) * 2 + (c >> 5), rr = r & 15, cc = c & 31, ob = rr * 64 + cc * 2; return st * 1024 + (ob ^ (((ob >> 9) & 1) << 5)); }
__host__ __device__ __forceinline__ void stage_rc(int b, int& R, int& C) { const int st = b / 1024, sb = b % 1024, swz = sb ^ (((sb >> 9) & 1) << 5); R = (st >> 1) * 16 + swz / 64; C = (st & 1) * 32 + (swz % 64) / 2; }
__host__ __device__ __forceinline__ int perm32(int rho) { const int n = rho >> 4, i = rho & 15; return 8 * (i >> 2) + 4 * n + (i & 3); }

typedef int i32x4v __attribute__((ext_vector_type(4)));
struct Unit { int pm, pn; };
typedef unsigned long long rss_t;
__device__ __forceinline__ float rstd_of(const rss_t* p) { const rss_t v = __hip_atomic_load((const GAS rss_t*)p, __ATOMIC_RELAXED, __HIP_MEMORY_SCOPE_AGENT); return 1.0f / sqrtf((float)v * (1.0f / 16777216.0f / 4096.0f) + 1e-6f); }
__device__ __forceinline__ rss_t ld_rss(const rss_t* p) { return __hip_atomic_load((const GAS rss_t*)p, __ATOMIC_RELAXED, __HIP_MEMORY_SCOPE_AGENT); }
#define PIN8(a) asm volatile("" : "+v"(a[0][0]), "+v"(a[0][1]), "+v"(a[0][2]), "+v"(a[0][3]), "+v"(a[1][0]), "+v"(a[1][1]), "+v"(a[1][2]), "+v"(a[1][3]) :: "memory")
#define PIN4(a) asm volatile("" : "+v"(a[0]), "+v"(a[1]), "+v"(a[2]), "+v"(a[3]) :: "memory")
__device__ __forceinline__ float rstd_v(rss_t v) { return 1.0f / sqrtf((float)v * (1.0f / 16777216.0f / 4096.0f) + 1e-6f); }
constexpr float I8_CLIP = 4.5f;
__device__ __forceinline__ float i8_row_step(const rss_t* p) { const rss_t v = __hip_atomic_load((const GAS rss_t*)p, __ATOMIC_RELAXED, __HIP_MEMORY_SCOPE_AGENT); return sqrtf((float)v * (1.0f / 16777216.0f / 4096.0f)) * (I8_CLIP / 127.0f) + 1e-20f; }
__device__ __forceinline__ float i8_step_v(rss_t v) { return sqrtf((float)v * (1.0f / 16777216.0f / 4096.0f)) * (I8_CLIP / 127.0f) + 1e-20f; }
__device__ __forceinline__ unsigned q8(float x, float inv) { const float r = __builtin_amdgcn_fmed3f(__builtin_rintf(x * inv), -127.0f, 127.0f); return (unsigned)(int)r & 0xffu; }
__device__ __forceinline__ unsigned pack_i8x4(float a, float b, float c, float d, float inv) { return q8(a, inv) | (q8(b, inv) << 8) | (q8(c, inv) << 16) | (q8(d, inv) << 24); }
__device__ __forceinline__ rss_t rss_fix(float v) { return (rss_t)(v * 16777216.0f + 0.5f); }
__device__ __forceinline__ void rss_add(rss_t* p, float v) { (void)__hip_atomic_fetch_add((GAS rss_t*)p, rss_fix(v), __ATOMIC_RELAXED, __HIP_MEMORY_SCOPE_AGENT); }
struct Gemm { const bf16_t* A; const bf16_t* Bt; int lda, ldb, M, N, K, gshift, gcols, bshift, bstride; };

struct StaticOrder {
    int nM, nN, nwg, G, c;
    __host__ __device__ void init(int M, int N, int G_, int c_) { nM = M / BM; nN = N / BM; nwg = nM * nN; G = G_; c = c_; }
    __host__ __device__ bool next(int i, Unit& u) const {
        const long L = (long)i * G + c; if (L >= nwg) return false;
        int wgid = (int)L; { const int q = nwg / NXCD, r = nwg % NXCD, xcd = wgid % NXCD, off = wgid / NXCD; wgid = (xcd < r ? xcd * (q + 1) : r * (q + 1) + (xcd - r) * q) + off; }
        const int nig = WGM * nN, gid = wgid / nig, fm = gid * WGM, gsz = (nM - fm) < WGM ? (nM - fm) : WGM;
        u.pm = fm + ((wgid % nig) % gsz); u.pn = (wgid % nig) / gsz; return true;
    }
};

struct EpiSplit {
    static constexpr bool PERM = true;
    bf16_t* p0; bf16_t* p1; bf16_t* p2; int ld0, ld1, ld2, t1, t2, rshift, rstride;
    const rss_t* rss; int smode;
    unsigned* rowmax; int rmshift, rmstride;
    const unsigned* cmax; const rss_t* rssq;
    __device__ __forceinline__ void operator()(const f32x4 (&acc)[2][2][4][2], const Unit& u, int wr, int wc, int fr, int fq) const {
        bf16_t* base; int ldc, colt;
        if (u.pn < t1) { base = p0; ldc = ld0; colt = u.pn * BM; }
        else if (u.pn < t2) { base = p1; ldc = ld1; colt = (u.pn - t1) * BM; }
        else { base = p2; ldc = ld2; colt = (u.pn - t2) * BM; }
        base += (size_t)(u.pm >> rshift) * rstride;
        const int row0 = u.pm * BM + wr * 64 + fr, col0 = colt + wc * 32 + 8 * fq, gcol0 = u.pn * BM + wc * 32 + 8 * fq;
        f32x4 cs[2][2];
#pragma unroll
        for (int bj = 0; bj < 2; ++bj)
#pragma unroll
            for (int n = 0; n < 2; ++n) { cs[bj][n] = (f32x4){1.f, 1.f, 1.f, 1.f};
                if (smode == 2) {
#pragma unroll
                    for (int e = 0; e < 4; ++e) { const int c = gcol0 + bj * HALF + 4 * n + e; cs[bj][n][e] = rstd_of(rss + c) * (cmax ? i8_row_step(rssq + c) : 1.0f); } }
                else if (cmax) { const u32x4 cm = *(const GAS u32x4*)(cmax + gcol0 + bj * HALF + 4 * n); cs[bj][n] = (f32x4){__uint_as_float(cm.x), __uint_as_float(cm.y), __uint_as_float(cm.z), __uint_as_float(cm.w)} * (1.0f / 127.0f); } }
        float rsv[2][4];
        { rss_t ra[2][4], rq[2][4]; unsigned rc[2][4];
#pragma unroll
          for (int ai = 0; ai < 2; ++ai)
#pragma unroll
              for (int m = 0; m < 4; ++m) { const int row = row0 + ai * HALF + m * 16; ra[ai][m] = 0; rq[ai][m] = 0; rc[ai][m] = 0;
                  if (smode == 1) { ra[ai][m] = ld_rss(rss + row); if (cmax) rq[ai][m] = ld_rss(rssq + row); }
                  else if (cmax) rc[ai][m] = __hip_atomic_load((const GAS unsigned*)cmax + row, __ATOMIC_RELAXED, __HIP_MEMORY_SCOPE_AGENT); }
          PIN8(ra); PIN8(rq);
#pragma unroll
          for (int ai = 0; ai < 2; ++ai)
#pragma unroll
              for (int m = 0; m < 4; ++m) { float rs = 1.f;
                  if (smode == 1) rs = rstd_v(ra[ai][m]) * (cmax ? i8_step_v(rq[ai][m]) : 1.0f);
                  else if (cmax) rs = __uint_as_float(rc[ai][m]) * (1.0f / 127.0f);
                  rsv[ai][m] = rs; } }
#pragma unroll
        for (int ai = 0; ai < 2; ++ai)
#pragma unroll
            for (int m = 0; m < 4; ++m) { const int row = row0 + ai * HALF + m * 16; bf16_t* rowp = base + (size_t)row * ldc + col0;
                const float rs = rsv[ai][m]; float rmx = 0.f;
#pragma unroll
                for (int bj = 0; bj < 2; ++bj) { f32x4 v0 = acc[ai][bj][m][0], v1 = acc[ai][bj][m][1];
                    if (cmax) { v0 = __builtin_convertvector(__builtin_bit_cast(i32x4v, v0), f32x4); v1 = __builtin_convertvector(__builtin_bit_cast(i32x4v, v1), f32x4); }
                    v0 = v0 * cs[bj][0] * rs; v1 = v1 * cs[bj][1] * rs;
                    u32x4 w; w.x = cvt_pk_bf16(v0[0], v0[1]); w.y = cvt_pk_bf16(v0[2], v0[3]); w.z = cvt_pk_bf16(v1[0], v1[1]); w.w = cvt_pk_bf16(v1[2], v1[3]);
                    *(GAS u32x4*)(rowp + bj * HALF) = w;
                    if (rowmax) { const float a = fmaxf(fmaxf(fmaxf(fabsf(bf_lo(w.x)), fabsf(bf_hi(w.x))), fmaxf(fabsf(bf_lo(w.y)), fabsf(bf_hi(w.y)))), fmaxf(fmaxf(fabsf(bf_lo(w.z)), fabsf(bf_hi(w.z))), fmaxf(fabsf(bf_lo(w.w)), fabsf(bf_hi(w.w))))); rmx = fmaxf(rmx, a); } }
                if (rowmax) { rmx = fmaxf(rmx, __shfl_xor(rmx, 16)); rmx = fmaxf(rmx, __shfl_xor(rmx, 32));
                    if (fq == 0) __hip_atomic_fetch_max((GAS unsigned*)rowmax + row + (size_t)(u.pm >> rmshift) * rmstride, __float_as_uint(rmx), __ATOMIC_RELAXED, __HIP_MEMORY_SCOPE_AGENT); } }
    }
};
struct EpiRes {
    static constexpr bool PERM = true;
    const bf16_t* base; bf16_t* xb; rss_t* rss; int ldc; unsigned char* xb8; int q8mode; const rss_t* rss0;
    __device__ __forceinline__ void operator()(const f32x4 (&acc)[2][2][4][2], const Unit& u, int wr, int wc, int fr, int fq) const {
        const int row0 = u.pm * BM + wr * 64 + fr, col0 = u.pn * BM + wc * 32 + 8 * fq;
        float qinvv[2][4];
        { rss_t r0v[2][4];
#pragma unroll
          for (int ai = 0; ai < 2; ++ai)
#pragma unroll
              for (int m = 0; m < 4; ++m) r0v[ai][m] = (xb8 && q8mode == 2) ? ld_rss(rss0 + row0 + ai * HALF + m * 16) : (rss_t)0;
          PIN8(r0v);
#pragma unroll
          for (int ai = 0; ai < 2; ++ai)
#pragma unroll
              for (int m = 0; m < 4; ++m) qinvv[ai][m] = (xb8 && q8mode == 2) ? 1.0f / i8_step_v(r0v[ai][m]) : 0.f; }
#pragma unroll
        for (int ai = 0; ai < 2; ++ai) {
            u32x4 b[4][2];
#pragma unroll
            for (int m = 0; m < 4; ++m)
#pragma unroll
                for (int bj = 0; bj < 2; ++bj) b[m][bj] = *(const GAS u32x4*)(base + (size_t)(row0 + ai * HALF + m * 16) * ldc + col0 + bj * HALF);
#pragma unroll
            for (int m = 0; m < 4; ++m) { const int row = row0 + ai * HALF + m * 16; const size_t off = (size_t)row * ldc + col0;
                float ss = 0.f; const float qinv = qinvv[ai][m];
#pragma unroll
                for (int bj = 0; bj < 2; ++bj) { const f32x4 a0 = acc[ai][bj][m][0], a1 = acc[ai][bj][m][1]; const u32x4 q = b[m][bj];
                    u32x4 w; w.x = cvt_pk_bf16(bf_lo(q.x) + a0[0], bf_hi(q.x) + a0[1]); w.y = cvt_pk_bf16(bf_lo(q.y) + a0[2], bf_hi(q.y) + a0[3]);
                    w.z = cvt_pk_bf16(bf_lo(q.z) + a1[0], bf_hi(q.z) + a1[1]); w.w = cvt_pk_bf16(bf_lo(q.w) + a1[2], bf_hi(q.w) + a1[3]);
                    *(GAS u32x4*)(xb + off + bj * HALF) = w;
                    const float r0 = bf_lo(w.x), r1 = bf_hi(w.x), r2 = bf_lo(w.y), r3 = bf_hi(w.y), r4 = bf_lo(w.z), r5 = bf_hi(w.z), r6 = bf_lo(w.w), r7 = bf_hi(w.w);
                    ss += (r0 * r0 + r1 * r1) + (r2 * r2 + r3 * r3) + (r4 * r4 + r5 * r5) + (r6 * r6 + r7 * r7);
                    if (xb8 && q8mode == 2) { *(GAS u32x2*)(xb8 + off + bj * HALF) = (u32x2){pack_i8x4(r0, r1, r2, r3, qinv), pack_i8x4(r4, r5, r6, r7, qinv)}; }
                    else if (xb8) { unsigned p0 = 0u, p1 = 0u;
                        p0 = __builtin_amdgcn_cvt_pk_fp8_f32(r0 * 8.f, r1 * 8.f, p0, false); p0 = __builtin_amdgcn_cvt_pk_fp8_f32(r2 * 8.f, r3 * 8.f, p0, true);
                        p1 = __builtin_amdgcn_cvt_pk_fp8_f32(r4 * 8.f, r5 * 8.f, p1, false); p1 = __builtin_amdgcn_cvt_pk_fp8_f32(r6 * 8.f, r7 * 8.f, p1, true);
                        *(GAS u32x2*)(xb8 + off + bj * HALF) = (u32x2){p0, p1}; } }
                ss += __shfl_xor(ss, 16); ss += __shfl_xor(ss, 32);
                if (fq == 0) rss_add(rss + row, ss); }
            asm volatile("" ::: "memory"); }
    }
};
struct EpiGate {
    static constexpr bool PERM = true;
    const bf16_t* x; const bf16_t* pp; const rss_t* rss_in; bf16_t* xb; rss_t* rss; float* outf; int ldc; float lscale; const unsigned* cmax; const rss_t* rss0; unsigned char* xq8;
    __device__ __forceinline__ void operator()(const f32x4 (&acc)[2][2][4][2], const Unit& u, int wr, int wc, int fr, int fq) const {
        const int row0 = u.pm * BM + wr * 64 + fr, col0 = u.pn * BM + wc * 32 + 8 * fq;
        f32x4 cs[2][2];
#pragma unroll
        for (int bj = 0; bj < 2; ++bj)
#pragma unroll
            for (int n = 0; n < 2; ++n) { cs[bj][n] = (f32x4){1.f, 1.f, 1.f, 1.f};
                if (cmax) { const u32x4 cm = *(const GAS u32x4*)(cmax + col0 + bj * HALF + 4 * n); cs[bj][n] = (f32x4){__uint_as_float(cm.x), __uint_as_float(cm.y), __uint_as_float(cm.z), __uint_as_float(cm.w)} * (1.0f / 127.0f); } }
#pragma unroll
        for (int ai = 0; ai < 2; ++ai) {
            float rsv[4], qinvv[4];
            { rss_t rin[4], r0v[4];
#pragma unroll
              for (int m = 0; m < 4; ++m) { const int row = row0 + ai * HALF + m * 16; rin[m] = ld_rss(rss_in + row); r0v[m] = cmax ? ld_rss(rss0 + row) : (rss_t)0; }
              PIN4(rin); PIN4(r0v);
#pragma unroll
              for (int m = 0; m < 4; ++m) { rsv[m] = rstd_v(rin[m]) * (cmax ? i8_step_v(r0v[m]) : lscale); qinvv[m] = xq8 ? 1.0f / i8_step_v(rin[m]) : 0.f; } }
#pragma unroll
            for (int mh = 0; mh < 2; ++mh) {
                u32x4 b[2][2], q[2][2]; float rs[2];
#pragma unroll
                for (int ml = 0; ml < 2; ++ml) { const int row = row0 + ai * HALF + (2 * mh + ml) * 16; rs[ml] = rsv[2 * mh + ml];
#pragma unroll
                    for (int bj = 0; bj < 2; ++bj) { b[ml][bj] = *(const GAS u32x4*)(x + (size_t)row * ldc + col0 + bj * HALF); q[ml][bj] = *(const GAS u32x4*)(pp + (size_t)row * ldc + col0 + bj * HALF); } }
#pragma unroll
                for (int ml = 0; ml < 2; ++ml) { const int m = 2 * mh + ml, row = row0 + ai * HALF + m * 16; const size_t off = (size_t)row * ldc + col0;
                    float ss = 0.f; const float qinv = qinvv[m];
#pragma unroll
                    for (int bj = 0; bj < 2; ++bj) { f32x4 a0 = acc[ai][bj][m][0], a1 = acc[ai][bj][m][1];
                        if (cmax) { a0 = __builtin_convertvector(__builtin_bit_cast(i32x4v, a0), f32x4) * cs[bj][0]; a1 = __builtin_convertvector(__builtin_bit_cast(i32x4v, a1), f32x4) * cs[bj][1]; }
                        a0 = a0 * rs[ml]; a1 = a1 * rs[ml]; const u32x4 xx = b[ml][bj], pq = q[ml][bj]; f32x4 v0, v1;
                        v0[0] = bf_lo(xx.x) + bf_lo(pq.x) * sigmoidf_(a0[0]); v0[1] = bf_hi(xx.x) + bf_hi(pq.x) * sigmoidf_(a0[1]);
                        v0[2] = bf_lo(xx.y) + bf_lo(pq.y) * sigmoidf_(a0[2]); v0[3] = bf_hi(xx.y) + bf_hi(pq.y) * sigmoidf_(a0[3]);
                        v1[0] = bf_lo(xx.z) + bf_lo(pq.z) * sigmoidf_(a1[0]); v1[1] = bf_hi(xx.z) + bf_hi(pq.z) * sigmoidf_(a1[1]);
                        v1[2] = bf_lo(xx.w) + bf_lo(pq.w) * sigmoidf_(a1[2]); v1[3] = bf_hi(xx.w) + bf_hi(pq.w) * sigmoidf_(a1[3]);
                        if (xb) {
                            u32x4 w; w.x = cvt_pk_bf16(v0[0], v0[1]); w.y = cvt_pk_bf16(v0[2], v0[3]); w.z = cvt_pk_bf16(v1[0], v1[1]); w.w = cvt_pk_bf16(v1[2], v1[3]);
                            *(GAS u32x4*)(xb + off + bj * HALF) = w;
                            const float r0 = bf_lo(w.x), r1 = bf_hi(w.x), r2 = bf_lo(w.y), r3 = bf_hi(w.y), r4 = bf_lo(w.z), r5 = bf_hi(w.z), r6 = bf_lo(w.w), r7 = bf_hi(w.w);
                            ss += (r0 * r0 + r1 * r1) + (r2 * r2 + r3 * r3) + (r4 * r4 + r5 * r5) + (r6 * r6 + r7 * r7);
                            if (xq8) *(GAS u32x2*)(xq8 + off + bj * HALF) = (u32x2){pack_i8x4(r0, r1, r2, r3, qinv), pack_i8x4(r4, r5, r6, r7, qinv)};
                        } else { *(GAS f32x4*)(outf + off + bj * HALF) = v0; *(GAS f32x4*)(outf + off + bj * HALF + 4) = v1; } }
                    if (xb) { ss += __shfl_xor(ss, 16); ss += __shfl_xor(ss, 32); if (fq == 0) rss_add(rss + row, ss); } }
                asm volatile("" ::: "memory"); } }
    }
};
struct EpiGrp {
    static constexpr bool PERM = true;
    bf16_t* O; const bf16_t* z; const float* scale; int ldc;
    __device__ __forceinline__ void operator()(const f32x4 (&acc)[2][2][4][2], const Unit& u, int wr, int wc, int fr, int fq) const {
        const int row0 = u.pm * BM + wr * 64 + fr, col0 = u.pn * BM + wc * 32 + 8 * fq;
        f32x4 sc[2][2];
#pragma unroll
        for (int bj = 0; bj < 2; ++bj)
#pragma unroll
            for (int n = 0; n < 2; ++n) sc[bj][n] = *(const GAS f32x4*)(scale + col0 + bj * HALF + 4 * n);
#pragma unroll
        for (int ai = 0; ai < 2; ++ai)
#pragma unroll
            for (int m = 0; m < 4; ++m) { const size_t off = (size_t)(row0 + ai * HALF + m * 16) * ldc + col0;
                u32x4 zz[2];
#pragma unroll
                for (int bj = 0; bj < 2; ++bj) zz[bj] = *(const GAS u32x4*)(z + off + bj * HALF);
#pragma unroll
                for (int bj = 0; bj < 2; ++bj) { const f32x4 v0 = acc[ai][bj][m][0] * sc[bj][0], v1 = acc[ai][bj][m][1] * sc[bj][1]; const u32x4 zw = zz[bj];
                    u32x4 w;
                    w.x = cvt_pk_bf16(v0[0] * siluf_(bf_lo(zw.x)), v0[1] * siluf_(bf_hi(zw.x))); w.y = cvt_pk_bf16(v0[2] * siluf_(bf_lo(zw.y)), v0[3] * siluf_(bf_hi(zw.y)));
                    w.z = cvt_pk_bf16(v1[0] * siluf_(bf_lo(zw.z)), v1[1] * siluf_(bf_hi(zw.z))); w.w = cvt_pk_bf16(v1[2] * siluf_(bf_lo(zw.w)), v1[3] * siluf_(bf_hi(zw.w)));
                    *(GAS u32x4*)(O + off + bj * HALF) = w; }
                if (m & 1) asm volatile("" ::: "memory"); }
    }
};

typedef int i32x8 __attribute__((ext_vector_type(8)));
__device__ __forceinline__ i32x8 cat8(const bf16x8 a, const bf16x8 b) { const i32x4v x = __builtin_bit_cast(i32x4v, a), y = __builtin_bit_cast(i32x4v, b); return (i32x8){x[0], x[1], x[2], x[3], y[0], y[1], y[2], y[3]}; }
template <class Epi, bool ALIGN_EPI = true, int MODE = 0>
__device__ __forceinline__ void gemm_phase(LAS unsigned char* lds, const Gemm g, const StaticOrder& S, const Epi& E, const int tid_in) {
    constexpr bool FP8 = (MODE == 1), I8 = (MODE == 2);
    int tid = tid_in; asm volatile("" : "+v"(tid));
    const int wid = __builtin_amdgcn_readfirstlane(tid >> 6), lane = tid & 63, wr = wid >> 2, wc = wid & 3, fr = lane & 15, fq = lane >> 4;
    const int K = g.K, nt = K / BK;
    unsigned voffA[2], voffB[2];
#pragma unroll
    for (int i = 0; i < 2; ++i) { int R, C; stage_rc(tid * 16 + i * 8192, R, C); const int Rb = Epi::PERM ? ((R & ~31) + perm32(R & 31)) : R;
        voffA[i] = (unsigned)(R * g.lda + C) * 2u; voffB[i] = (unsigned)(Rb * g.ldb + C) * 2u; }
    const size_t kstep = (size_t)(BK * 2);
    const size_t hstepA = (size_t)HALF * g.lda * 2, hstepB = (size_t)HALF * g.ldb * 2;
    const size_t tstepA = 2 * hstepA, tstepB = 2 * hstepB;
    const unsigned ldsw = (unsigned)wid * 1024u;
    const int aoff = lds_byte(wr * 64 + fr, fq * 8), boff = lds_byte(wc * 32 + fr, fq * 8);
#define PG8_SA(b, h) (((b) * 2 + (h)) * HTB)
#define PG8_SB(b, h) ((4 + (b) * 2 + (h)) * HTB)
#define PG8_STAGE(bufoff, gbase, voff) do { _Pragma("unroll") for (int _i = 0; _i < 2; ++_i) \
        { if constexpr (FP8) __builtin_amdgcn_global_load_lds((const GAS unsigned*)((const GAS char*)(gbase) + (voff)[_i]), (LAS unsigned*)(lds + (bufoff) + ldsw + _i * 8192), 16, 0, 0);   \
          else __builtin_amdgcn_global_load_lds((const unsigned*)((const char*)(gbase) + (voff)[_i]), (LAS unsigned*)(lds + (bufoff) + ldsw + _i * 8192), 16, 0, 0); } } while (0)
#define PG8_LD8(p) __builtin_shufflevector(*(const LAS i32x4v*)(p), *(const LAS i32x4v*)((p) + 1024), 0, 1, 2, 3, 4, 5, 6, 7)
#define PG8_LDA(dst, b, h) do { if constexpr (FP8) { _Pragma("unroll") for (int m = 0; m < 4; ++m) dst##8[m] = PG8_LD8(lds + PG8_SA(b, h) + aoff + m * 2048); } else { _Pragma("unroll") for (int m = 0; m < 4; ++m) _Pragma("unroll") for (int k = 0; k < 2; ++k) dst[m][k] = *(const LAS bf16x8*)(lds + PG8_SA(b, h) + aoff + m * 2048 + k * 1024); } } while (0)
#define PG8_LDB(dst, b, h) do { if constexpr (FP8) { _Pragma("unroll") for (int n = 0; n < 2; ++n) dst##8[n] = PG8_LD8(lds + PG8_SB(b, h) + boff + n * 2048); } else { _Pragma("unroll") for (int n = 0; n < 2; ++n) _Pragma("unroll") for (int k = 0; k < 2; ++k) dst[n][k] = *(const LAS bf16x8*)(lds + PG8_SB(b, h) + boff + n * 2048 + k * 1024); } } while (0)
#define PG8_MMA(ai, bj, At, Bt) do { __builtin_amdgcn_s_setprio(0);   if constexpr (FP8) { _Pragma("unroll") for (int m = 0; m < 4; ++m) _Pragma("unroll") for (int n = 0; n < 2; ++n) \
        asm volatile("v_mfma_scale_f32_16x16x128_f8f6f4 %0, %1, %2, %0, %3, %3 op_sel_hi:[0,0,0]" : "+v"(acc[ai][bj][m][n]) : "v"(Bt##8[n]), "v"(At##8[m]), "v"(0x7F7F7F7F)); } else { \
        _Pragma("unroll") for (int m = 0; m < 4; ++m) _Pragma("unroll") for (int n = 0; n < 2; ++n) _Pragma("unroll") for (int k = 0; k < 2; ++k) { \
        if constexpr (I8) acc[ai][bj][m][n] = __builtin_bit_cast(f32x4, __builtin_amdgcn_mfma_i32_16x16x64_i8(__builtin_bit_cast(i32x4v, Bt[n][k]), __builtin_bit_cast(i32x4v, At[m][k]), __builtin_bit_cast(i32x4v, acc[ai][bj][m][n]), 0, 0, 0)); \
        else acc[ai][bj][m][n] = __builtin_amdgcn_mfma_f32_16x16x32_f16(Bt[n][k], At[m][k], acc[ai][bj][m][n], 0, 0, 0); } } __builtin_amdgcn_s_setprio(0); } while (0)
#define PG8_WAIT_V(n) asm volatile("s_waitcnt vmcnt(" #n ")" ::: "memory")
#define PG8_WAIT_L(n) asm volatile("s_waitcnt lgkmcnt(" #n ")" ::: "memory")
#define PG8_BAR __builtin_amdgcn_s_barrier()
#define PG8_SCHED __builtin_amdgcn_sched_barrier(0)
#define PG8_ABASE(u) ((const char*)g.A + (size_t)(u).pm * tstepA + (size_t)((u).pn >> g.gshift) * g.gcols * 2)
#define PG8_BBASE(u) ((const char*)g.Bt + (size_t)(u).pn * tstepB + (size_t)((u).pm >> g.bshift) * g.bstride * 2)
    Unit cur, nxt; int ui = 0;
    if (!S.next(0, cur)) return;
    f32x4 acc[2][2][4][2];
#pragma unroll
    for (int a = 0; a < 2; ++a)
#pragma unroll
        for (int b = 0; b < 2; ++b)
#pragma unroll
            for (int m = 0; m < 4; ++m)
#pragma unroll
                for (int n = 0; n < 2; ++n) acc[a][b][m][n] = (f32x4){0.f, 0.f, 0.f, 0.f};
    bf16x8 At[4][2], B0[2][2], B1[2][2]; i32x8 At8[4], B08[2], B18[2];
    const char* cA = PG8_ABASE(cur); const char* cB = PG8_BBASE(cur);
    PG8_STAGE(PG8_SB(0, 0), cB, voffB); PG8_STAGE(PG8_SB(0, 1), cB + hstepB, voffB); PG8_STAGE(PG8_SA(0, 0), cA, voffA); PG8_STAGE(PG8_SA(0, 1), cA + hstepA, voffA);
    if (wr == 1) PG8_BAR;
    PG8_WAIT_V(2); PG8_BAR;
    PG8_STAGE(PG8_SB(1, 0), cB + kstep, voffB); PG8_STAGE(PG8_SA(1, 0), cA + kstep, voffA); PG8_STAGE(PG8_SB(1, 1), cB + hstepB + kstep, voffB);
    PG8_WAIT_V(6); PG8_BAR;
    for (;;) {
        const bool has_next = S.next(ui + 1, nxt);
        const char* nA = has_next ? PG8_ABASE(nxt) : cA; const char* nB = has_next ? PG8_BBASE(nxt) : cB;
        const long kinc = (ui & 1) ? -(long)kstep : (long)kstep, nkinc = has_next ? -kinc : kinc;
        const char* sA = cA + ((ui & 1) ? (size_t)(nt - 1) * kstep : 0); const char* sB = cB + ((ui & 1) ? (size_t)(nt - 1) * kstep : 0);
        const char* nsA = has_next ? nA + ((ui & 1) ? 0 : (size_t)(nt - 1) * kstep) : sA; const char* nsB = has_next ? nB + ((ui & 1) ? 0 : (size_t)(nt - 1) * kstep) : sB;
        const char* pA = sA; const char* pB = sB;
        for (int t = 0; t < nt; t += 2, pA += 2 * kinc, pB += 2 * kinc) {
            const bool last = (t == nt - 2);
            const char* a1 = pA + kinc;
            const char* a2 = last ? nsA : pA + 2 * kinc; const char* b2 = last ? nsB : pB + 2 * kinc;
            const char* a3 = a2 + (last ? nkinc : kinc); const char* b3 = b2 + (last ? nkinc : kinc);
            PG8_LDB(B0, 0, 0); PG8_LDB(B1, 0, 1); PG8_SCHED; PG8_LDA(At, 0, 0); PG8_STAGE(PG8_SA(1, 1), a1 + hstepA, voffA);
            PG8_WAIT_V(8); PG8_WAIT_L(0); PG8_BAR; PG8_MMA(0, 0, At, B0); PG8_MMA(0, 1, At, B1); PG8_BAR; PG8_SCHED;
            PG8_LDA(At, 0, 1); PG8_STAGE(PG8_SB(0, 0), b2, voffB); PG8_STAGE(PG8_SB(0, 1), b2 + hstepB, voffB); PG8_STAGE(PG8_SA(0, 0), a2, voffA);
            PG8_WAIT_V(8); PG8_WAIT_L(0); PG8_BAR; PG8_MMA(1, 0, At, B0); PG8_MMA(1, 1, At, B1); PG8_BAR; PG8_SCHED;
            PG8_LDB(B0, 1, 0); PG8_LDB(B1, 1, 1); PG8_SCHED; PG8_LDA(At, 1, 0); PG8_STAGE(PG8_SA(0, 1), a2 + hstepA, voffA);
            PG8_WAIT_V(8); PG8_WAIT_L(0); PG8_BAR; PG8_MMA(0, 0, At, B0); PG8_MMA(0, 1, At, B1); PG8_BAR; PG8_SCHED;
            PG8_LDA(At, 1, 1); PG8_STAGE(PG8_SB(1, 0), b3, voffB); PG8_STAGE(PG8_SB(1, 1), b3 + hstepB, voffB); PG8_STAGE(PG8_SA(1, 0), a3, voffA);
            PG8_WAIT_V(8); PG8_WAIT_L(0); PG8_BAR; PG8_MMA(1, 0, At, B0); PG8_MMA(1, 1, At, B1); PG8_BAR; PG8_SCHED;
        }
        if constexpr (FP8) asm volatile("s_nop 15\n\ts_nop 15" ::: "memory");
        if constexpr (ALIGN_EPI) { if (wr == 0) PG8_BAR; }
        if constexpr (FP8) { const int le = lane_id(); E(acc, cur, wr, wc, le & 15, le >> 4); } else E(acc, cur, wr, wc, fr, fq);
        if (!has_next) break;
#pragma unroll
        for (int a = 0; a < 2; ++a)
#pragma unroll
            for (int b = 0; b < 2; ++b)
#pragma unroll
                for (int m = 0; m < 4; ++m)
#pragma unroll
                    for (int n = 0; n < 2; ++n) acc[a][b][m][n] = (f32x4){0.f, 0.f, 0.f, 0.f};
        cur = nxt; cA = nA; cB = nB; ++ui;
        if constexpr (ALIGN_EPI) { if (wr == 1) PG8_BAR; }
    }
    PG8_WAIT_V(0);
    if constexpr (!ALIGN_EPI) { if (wr == 0) PG8_BAR; }
    PG8_BAR;
#undef PG8_SA
#undef PG8_SB
#undef PG8_STAGE
#undef PG8_LDA
#undef PG8_LDB
#undef PG8_MMA
#undef PG8_WAIT_V
#undef PG8_WAIT_L
#undef PG8_BAR
#undef PG8_SCHED
#undef PG8_ABASE
#undef PG8_BBASE
}
}

#define XB_TMO      128
#define XB_XCNT(j)  (256  + 64 * (j))
#define XB_XSUB(j)  (1280 + 64 * (j))
#define XB_XGEN(j)  (2304 + 64 * (j))
#define XB_TOP      3328
#define XB_TOPGEN   3392
#define XCD_BAR_WORDS 3456
#define XB_SPIN_CAP (1u << 18)

__device__ __forceinline__ unsigned xb_ld(unsigned* p)              { return __hip_atomic_load(p, __ATOMIC_RELAXED, __HIP_MEMORY_SCOPE_AGENT); }
__device__ __forceinline__ unsigned xb_add(unsigned* p, unsigned v) { return __hip_atomic_fetch_add(p, v, __ATOMIC_RELAXED, __HIP_MEMORY_SCOPE_AGENT); }
__device__ __forceinline__ unsigned xb_xcc_id() { return (unsigned)__builtin_amdgcn_s_getreg((3 << 11) | 20) & 0xFu; }
#define XB_SPIN(cond, bar) do { unsigned _sp = 0; while (cond) { __builtin_amdgcn_s_sleep(1); \
    if ((++_sp & 255u) == 0u) { if (xb_ld(&(bar)[XB_TMO])) break; if (_sp > XB_SPIN_CAP) { atomicAdd(&(bar)[XB_TMO], 1u); break; } } } } while (0)

struct XcdBarrier {
    unsigned* bar; unsigned x;
    volatile LAS unsigned* st;
    int wave;
};
__device__ __forceinline__ int lane_id() { unsigned m = ~0u; asm volatile("" : "+s"(m)); return (int)__builtin_amdgcn_mbcnt_hi(m, __builtin_amdgcn_mbcnt_lo(m, 0u)); }
#define XB_T0(b) ((b).wave == 0 && lane_id() == 0)
__device__ __forceinline__ XcdBarrier xcd_barrier_post(unsigned* bar, volatile LAS unsigned* st, int wave) {
    XcdBarrier b; b.bar = bar; b.x = xb_xcc_id(); b.st = st; b.wave = wave;
    if (XB_T0(b)) (void)xb_add(&bar[XB_XCNT(b.x)], 1u);
    return b;
}
__device__ __forceinline__ void xcd_barrier_complete(unsigned* bar, unsigned x, unsigned& nloc, unsigned& nx) {
    const unsigned G = gridDim.x * gridDim.y * gridDim.z;
    unsigned sum, cnt, mine, sp = 0u;
    for (;;) {
        sum = 0u; cnt = 0u; mine = 0u;
#pragma unroll
        for (unsigned j = 0; j < 16; ++j) { const unsigned c = xb_ld(&bar[XB_XCNT(j)]); sum += c; cnt += (c > 0u) ? 1u : 0u; mine = (j == x) ? c : mine; }
        if (sum == G) break;
        __builtin_amdgcn_s_sleep(1);
        if ((++sp & 255u) == 0u) { if (xb_ld(&bar[XB_TMO])) break; if (sp > XB_SPIN_CAP) { atomicAdd(&bar[XB_TMO], 1u); break; } }
    }
    nloc = mine > 0u ? mine : 1u; nx = cnt > 0u ? cnt : 1u;
}
__device__ __forceinline__ void xcd_barrier(const XcdBarrier& b) {
    asm volatile("s_waitcnt vmcnt(0)" ::: "memory");
    __syncthreads();
    if (XB_T0(b)) {
        unsigned* bar = b.bar;
        __builtin_amdgcn_s_waitcnt(0);
        unsigned nloc = b.st[0], nx = b.st[1];
        if (nloc == 0u) { xcd_barrier_complete(bar, b.x, nloc, nx); b.st[0] = nloc; b.st[1] = nx; }
        const unsigned old = xb_add(&bar[XB_XSUB(b.x)], 1u);
        const unsigned gen = old / nloc;
        if (old + 1u == (gen + 1u) * nloc) {
            __builtin_amdgcn_fence(__ATOMIC_RELEASE, "agent");
            asm volatile("s_waitcnt vmcnt(0)" ::: "memory");
            const unsigned og = xb_add(&bar[XB_TOP], 1u);
            const unsigned tg = og / nx;
            if (og + 1u == (tg + 1u) * nx) xb_add(&bar[XB_TOPGEN], 1u);
            else XB_SPIN(xb_ld(&bar[XB_TOPGEN]) == tg, bar);
            __builtin_amdgcn_fence(__ATOMIC_ACQUIRE, "agent");
            xb_add(&bar[XB_XGEN(b.x)], 1u);
            asm volatile("s_waitcnt vmcnt(0)" ::: "memory");
        } else {
            XB_SPIN(xb_ld(&bar[XB_XGEN(b.x)]) == gen, bar);
            __builtin_amdgcn_fence(__ATOMIC_ACQUIRE, "agent");
            asm volatile("s_waitcnt vmcnt(0)" ::: "memory");
        }
    }
    __syncthreads();
}

__device__ __forceinline__ unsigned f2bf(float f) { unsigned u = __builtin_bit_cast(unsigned, f); return (u + 0x7fffu + ((u >> 16) & 1u)) >> 16; }
__device__ __forceinline__ unsigned pk2(float lo, float hi) { return f2bf(lo) | (f2bf(hi) << 16); }
__device__ __forceinline__ void transpose_batch(const float* W, int nbatch, int K, int N, bf16* WT, int remap, LAS float* scr, int gw, int NGW, int lane, int nb_lo = 0, int nb_cnt = -1, const float* gk = nullptr, int gstride = 0, unsigned f8mask = 0u, unsigned i8mask = 0u, const unsigned* cmax = nullptr) {
    const int nblk = nb_cnt < 0 ? N / 32 : nb_cnt, kblk = K / 64, per = nblk * kblk, total = per * nbatch;
    const int rr = lane >> 3, c4 = lane & 7;
    f32x4 cur[8], nxt[8]; float gc[8], gn[8];
#define TB_DECODE(it_, b_, k0_, nb_) const int b_ = (it_) / per, _r##b_ = (it_) - b_ * per, _kb##b_ = _r##b_ / nblk, nb_ = nb_lo + (_r##b_ - _kb##b_ * nblk), k0_ = 64 * _kb##b_
#define TB_LOAD(dst, gd, b_, k0_, nb_) do { const GAS char* _ub = (const GAS char*)W + ((size_t)(b_) * K * N + (size_t)(k0_) * N + 32 * (nb_)) * 4;     \
        int _rr = rr; asm volatile("" : "+v"(_rr)); const unsigned _vo = (unsigned)(_rr * N + 4 * c4) * 4u;     \
        _Pragma("unroll") for (int i = 0; i < 8; ++i) dst[i] = *(const GAS f32x4*)(_ub + (size_t)(8 * i) * N * 4 + _vo); \
        if (gk) { const GAS float* _g = (const GAS float*)gk + (size_t)(b_) * gstride + (k0_) + rr; _Pragma("unroll") for (int i = 0; i < 8; ++i) gd[i] = _g[8 * i]; } \
        else { _Pragma("unroll") for (int i = 0; i < 8; ++i) gd[i] = 1.0f; } } while (0)
    int it = gw;
    if (it < total) { TB_DECODE(it, b0, k00, nb0); TB_LOAD(cur, gc, b0, k00, nb0); }
    while (it < total) {
        const int itn = it + NGW;
        if (itn < total) { TB_DECODE(itn, b1, k01, nb1); TB_LOAD(nxt, gn, b1, k01, nb1); }
        TB_DECODE(it, b, k0, nb);
        int drow0 = 32 * nb;
        if (remap) { if (drow0 >= 6144) drow0 -= 1024; else if (drow0 >= 5120) drow0 += 4096; }
#pragma unroll
        for (int i = 0; i < 8; ++i) { LAS float* s = scr + (8 * i + rr) * 33 + 4 * c4; const f32x4 v = cur[i] * gc[i]; s[0] = v[0]; s[1] = v[1]; s[2] = v[2]; s[3] = v[3]; }
        asm volatile("s_waitcnt lgkmcnt(0)" ::: "memory");
        { const int c = lane & 7; bf16* wt = WT + (size_t)b * K * N;
          if ((i8mask >> b) & 1u) {
#pragma unroll
              for (int j = 0; j < 4; ++j) { const int n = (lane >> 3) + 8 * j; const LAS float* s = scr + (8 * c) * 33 + n;
                  const float cm = __uint_as_float(__hip_atomic_load((const GAS unsigned*)cmax + (size_t)b * N + drow0 + n, __ATOMIC_RELAXED, __HIP_MEMORY_SCOPE_AGENT)), inv = cm > 0.f ? 127.0f / cm : 0.f;
                  *(GAS u32x2*)((unsigned char*)wt + (size_t)(drow0 + n) * K + k0 + 8 * c) = (u32x2){pg8::pack_i8x4(s[0 * 33], s[1 * 33], s[2 * 33], s[3 * 33], inv), pg8::pack_i8x4(s[4 * 33], s[5 * 33], s[6 * 33], s[7 * 33], inv)}; }
          } else if ((f8mask >> b) & 1u) {
#pragma unroll
              for (int j = 0; j < 4; ++j) { const int n = (lane >> 3) + 8 * j; const LAS float* s = scr + (8 * c) * 33 + n; unsigned p0 = 0u, p1 = 0u;
                  p0 = __builtin_amdgcn_cvt_pk_fp8_f32(s[0 * 33] * 64.f, s[1 * 33] * 64.f, p0, false); p0 = __builtin_amdgcn_cvt_pk_fp8_f32(s[2 * 33] * 64.f, s[3 * 33] * 64.f, p0, true);
                  p1 = __builtin_amdgcn_cvt_pk_fp8_f32(s[4 * 33] * 64.f, s[5 * 33] * 64.f, p1, false); p1 = __builtin_amdgcn_cvt_pk_fp8_f32(s[6 * 33] * 64.f, s[7 * 33] * 64.f, p1, true);
                  *(GAS u32x2*)((unsigned char*)wt + (size_t)(drow0 + n) * K + k0 + 8 * c) = (u32x2){p0, p1}; }
          } else {
#pragma unroll
          for (int j = 0; j < 4; ++j) { const int n = (lane >> 3) + 8 * j; const LAS float* s = scr + (8 * c) * 33 + n;
              u32x4 o; o.x = cvt_pk_bf16(s[0 * 33], s[1 * 33]); o.y = cvt_pk_bf16(s[2 * 33], s[3 * 33]); o.z = cvt_pk_bf16(s[4 * 33], s[5 * 33]); o.w = cvt_pk_bf16(s[6 * 33], s[7 * 33]);
              *(GAS u32x4*)(wt + (size_t)(drow0 + n) * K + k0 + 8 * c) = o; } } }
        asm volatile("s_waitcnt lgkmcnt(0)" ::: "memory");
#pragma unroll
        for (int i = 0; i < 8; ++i) { cur[i] = nxt[i]; gc[i] = gn[i]; }
        it = itn;
    }
#undef TB_DECODE
#undef TB_LOAD
}
__device__ __forceinline__ void i8w_fused(const float* W, int nbat, unsigned bmask, int K, int ldw, int nb_lo, int nblk, int remap, const float* gk, int gstride, unsigned char* WTb, size_t wt_bstride, unsigned* cmax, int ostride, LAS unsigned char* lds, int vcu, int G, int tid_in, int task0 = 0) {
    int tid = tid_in; asm volatile("" : "+v"(tid));
    const int wave = __builtin_amdgcn_readfirstlane(tid >> 6), lane = tid & 63, rr = lane >> 3, c4 = lane & 7, kblk = K / 64;
    LAS float* scr = (LAS float*)(lds + wave * 16384); LAS float* cmw = (LAS float*)(lds + 131072); LAS float* cmf = cmw + 256;
    int first = vcu - (task0 % G); if (first < 0) first += G;
    for (int task = first; task < nbat * nblk; task += G) {
        const int b = task / nblk, nb = nb_lo + (task - b * nblk);
        if (!((bmask >> b) & 1u)) continue;
        int drow0 = 32 * nb;
        if (remap) { if (drow0 >= 6144) drow0 -= 1024; else if (drow0 >= 5120) drow0 += 4096; }
        const GAS char* ub = (const GAS char*)W + ((size_t)b * K * ldw + 32 * nb) * 4;
        const GAS float* gb = (const GAS float*)gk + (size_t)b * gstride;
#define I8F_LOAD(dst, gd, kb_) do { int _rr = rr; asm volatile("" : "+v"(_rr)); const unsigned _vo = (unsigned)(_rr * ldw + 4 * c4) * 4u; const GAS char* _ub = ub + (size_t)(kb_) * 64 * ldw * 4; \
        _Pragma("unroll") for (int i = 0; i < 8; ++i) dst[i] = *(const GAS f32x4*)(_ub + (size_t)(8 * i) * ldw * 4 + _vo); \
        _Pragma("unroll") for (int i = 0; i < 8; ++i) gd[i] = gb[(kb_) * 64 + 8 * i + _rr]; } while (0)
        f32x4 mx = (f32x4){0.f, 0.f, 0.f, 0.f};
        { f32x4 va[8], vb[8]; float ga[8], gbv[8];
#pragma nounroll
          for (int kb = wave; kb < kblk; kb += 16) {
              I8F_LOAD(va, ga, kb);
              const bool two = kb + 8 < kblk;
              if (two) I8F_LOAD(vb, gbv, kb + 8);
#pragma unroll
              for (int i = 0; i < 8; ++i) mx = __builtin_elementwise_max(mx, __builtin_elementwise_abs(va[i] * ga[i]));
              if (two) {
#pragma unroll
                  for (int i = 0; i < 8; ++i) mx = __builtin_elementwise_max(mx, __builtin_elementwise_abs(vb[i] * gbv[i])); } } }
#pragma unroll
        for (int sh = 8; sh < 64; sh <<= 1) {
#pragma unroll
            for (int e = 0; e < 4; ++e) mx[e] = fmaxf(mx[e], __shfl_xor(mx[e], sh)); }
        if (lane < 8) { LAS float* o = cmw + wave * 32 + 4 * c4; o[0] = mx[0]; o[1] = mx[1]; o[2] = mx[2]; o[3] = mx[3]; }
        __syncthreads();
        if (tid < 32) { float m = cmw[tid];
#pragma unroll
            for (int w = 1; w < 8; ++w) m = fmaxf(m, cmw[w * 32 + tid]);
            cmf[tid] = m; ((GAS unsigned*)cmax)[(size_t)b * ostride + drow0 + tid] = __float_as_uint(m); }
        __syncthreads();
        float inv[4];
#pragma unroll
        for (int j = 0; j < 4; ++j) { const float cm = cmf[rr + 8 * j]; inv[j] = cm > 0.f ? 127.0f / cm : 0.f; }
        { f32x4 cur[8], nxt[8]; float gc[8], gn[8];
          int kb = wave;
          if (kb < kblk) I8F_LOAD(cur, gc, kb);
#pragma nounroll
          while (kb < kblk) {
              const int kbn = kb + 8;
              if (kbn < kblk) I8F_LOAD(nxt, gn, kbn);
#pragma unroll
              for (int i = 0; i < 8; ++i) { LAS float* sp = scr + (8 * i + rr) * 33 + 4 * c4; const f32x4 v = cur[i] * gc[i]; sp[0] = v[0]; sp[1] = v[1]; sp[2] = v[2]; sp[3] = v[3]; }
              asm volatile("s_waitcnt lgkmcnt(0)" ::: "memory");
              unsigned char* wt = WTb + (size_t)b * wt_bstride;
#pragma unroll
              for (int j = 0; j < 4; ++j) { const int n = rr + 8 * j; const LAS float* sp = scr + (8 * c4) * 33 + n;
                  *(GAS u32x2*)(wt + (size_t)(drow0 + n) * K + 64 * kb + 8 * c4) = (u32x2){pg8::pack_i8x4(sp[0 * 33], sp[1 * 33], sp[2 * 33], sp[3 * 33], inv[j]), pg8::pack_i8x4(sp[4 * 33], sp[5 * 33], sp[6 * 33], sp[7 * 33], inv[j])}; }
              asm volatile("s_waitcnt lgkmcnt(0)" ::: "memory");
#pragma unroll
              for (int i = 0; i < 8; ++i) { cur[i] = nxt[i]; gc[i] = gn[i]; }
              kb = kbn; } }
#undef I8F_LOAD
    }
}
__device__ __forceinline__ void wq_rows(const bf16* src, unsigned char* dst, const unsigned* rowmax, int gw, int NGW, int lane) {
    for (int r = gw; r < POOLW; r += NGW) {
        const float cm = __uint_as_float(__hip_atomic_load((const GAS unsigned*)rowmax + r, __ATOMIC_RELAXED, __HIP_MEMORY_SCOPE_AGENT)), inv = cm > 0.f ? 127.0f / cm : 0.f;
        const GAS u32x4* s = (const GAS u32x4*)(src + (size_t)r * D) + lane; GAS u32x2* d = (GAS u32x2*)(dst + (size_t)r * D) + lane;
        u32x4 v[8];
#pragma unroll
        for (int i = 0; i < 8; ++i) v[i] = s[64 * i];
#pragma unroll
        for (int i = 0; i < 8; ++i) d[64 * i] = (u32x2){pg8::pack_i8x4(bf_lo(v[i].x), bf_hi(v[i].x), bf_lo(v[i].y), bf_hi(v[i].y), inv), pg8::pack_i8x4(bf_lo(v[i].z), bf_hi(v[i].z), bf_lo(v[i].w), bf_hi(v[i].w), inv)};
    }
}
__device__ __forceinline__ void xg_rows(const float* x, bf16* out, pg8::rss_t* rss, unsigned char* q8out, int gw, int NGW, int lane) {
    for (int m = gw; m < S; m += NGW) {
        const GAS f32x4* xr = (const GAS f32x4*)(x + (size_t)m * D) + lane;
        f32x4 v[16]; float s = 0.f;
        GAS u32x2* o8 = (GAS u32x2*)(out + (size_t)m * D) + lane;
#pragma unroll
        for (int j = 0; j < 16; ++j) v[j] = xr[64 * j];
#pragma unroll
        for (int j = 0; j < 16; ++j) { u32x2 w; w.x = cvt_pk_bf16(v[j][0], v[j][1]); w.y = cvt_pk_bf16(v[j][2], v[j][3]); o8[64 * j] = w;
            const float a0 = bf_lo(w.x), a1 = bf_hi(w.x), a2 = bf_lo(w.y), a3 = bf_hi(w.y); s += (a0 * a0 + a1 * a1) + (a2 * a2 + a3 * a3); }
        const float tot = wave_sum(s); const pg8::rss_t fx = pg8::rss_fix(tot); if (lane == 0) rss[m] = fx;
        if (q8out) {
            const float qinv = 1.0f / (sqrtf((float)fx * (1.0f / 16777216.0f / 4096.0f)) * (pg8::I8_CLIP / 127.0f) + 1e-20f);
            GAS unsigned* q = (GAS unsigned*)(q8out + (size_t)m * D) + lane;
#pragma unroll
            for (int j = 0; j < 16; ++j) { const unsigned w0 = cvt_pk_bf16(v[j][0], v[j][1]), w1 = cvt_pk_bf16(v[j][2], v[j][3]); q[64 * j] = pg8::pack_i8x4(bf_lo(w0), bf_hi(w0), bf_lo(w1), bf_hi(w1), qinv); } }
    }
}

__device__ __forceinline__ void acc8(float (&s)[8], const u32x4 q, const float w) {
    s[0] += w * bf_lo(q.x); s[1] += w * bf_hi(q.x); s[2] += w * bf_lo(q.y); s[3] += w * bf_hi(q.y); s[4] += w * bf_lo(q.z); s[5] += w * bf_hi(q.z); s[6] += w * bf_lo(q.w); s[7] += w * bf_hi(q.w);
}
__device__ __forceinline__ void poolgate_phase(const bf16* Y, const bf16* Z, const float* scale, bf16* G2, int vcu, int G, int tid) {
    constexpr int CH = 128;
    const int nunits = (S / CH) * 2;
    for (int u = vcu; u < nunits; u += G) {
        const int cb = u & 1, tc = u >> 1, t0 = tc * CH, c0 = cb * 4096 + tid * 8;
        const int j = c0 >> 11, w = 2 << j, left = (w - 1) >> 1, right = w - 1 - left;
        const bf16* yp = Y + c0; const bf16* zp = Z + c0; bf16* gp = G2 + c0;
        const f32x4 sc0 = *(const GAS f32x4*)(scale + c0), sc1 = *(const GAS f32x4*)(scale + c0 + 4);
        float sum[8];
#pragma unroll
        for (int e = 0; e < 8; ++e) sum[e] = 0.f;
        for (int s = t0 - left; s <= t0 + right; ++s) { const int sc = s < 0 ? 0 : (s >= S ? S - 1 : s); const float ws = (s >= 0 && s < S) ? 1.f : 0.f;
            acc8(sum, *(const GAS u32x4*)(yp + (size_t)sc * POOLW), ws); }
        for (int i0 = 0; i0 < CH; i0 += 8) {
            u32x4 cc[8], zz[8], qa[8], qd[8];
#pragma unroll
            for (int i = 0; i < 8; ++i) { const int t = t0 + i0 + i, sa = t + 1 + right, sd = t - left, sac = sa < S ? sa : S - 1, sdc = sd > 0 ? sd : 0;
                cc[i] = *(const GAS u32x4*)(yp + (size_t)t * POOLW); zz[i] = *(const GAS u32x4*)(zp + (size_t)t * POOLW);
                qa[i] = *(const GAS u32x4*)(yp + (size_t)sac * POOLW); qd[i] = *(const GAS u32x4*)(yp + (size_t)sdc * POOLW); }
#pragma unroll
            for (int i = 0; i < 8; ++i) { const int t = t0 + i0 + i, sa = t + 1 + right, sd = t - left;
                const int lo = (t - left) > 0 ? (t - left) : 0, hi = (t + right + 1) < S ? (t + right + 1) : S;
                const float inv = 1.0f / (float)(hi - lo);
                const u32x4 c = cc[i], z = zz[i];
                u32x4 o;
                o.x = cvt_pk_bf16((sum[0] * inv - bf_lo(c.x)) * sc0[0] * siluf_(bf_lo(z.x)), (sum[1] * inv - bf_hi(c.x)) * sc0[1] * siluf_(bf_hi(z.x)));
                o.y = cvt_pk_bf16((sum[2] * inv - bf_lo(c.y)) * sc0[2] * siluf_(bf_lo(z.y)), (sum[3] * inv - bf_hi(c.y)) * sc0[3] * siluf_(bf_hi(z.y)));
                o.z = cvt_pk_bf16((sum[4] * inv - bf_lo(c.z)) * sc1[0] * siluf_(bf_lo(z.z)), (sum[5] * inv - bf_hi(c.z)) * sc1[1] * siluf_(bf_hi(z.z)));
                o.w = cvt_pk_bf16((sum[6] * inv - bf_lo(c.w)) * sc1[2] * siluf_(bf_lo(z.w)), (sum[7] * inv - bf_hi(c.w)) * sc1[3] * siluf_(bf_hi(z.w)));
                *(GAS u32x4*)(gp + (size_t)t * POOLW) = o;
                acc8(sum, qa[i], sa < S ? 1.f : 0.f); acc8(sum, qd[i], sd >= 0 ? -1.f : 0.f); }
        }
    }
}

namespace att {
constexpr int KROW = 136, VROW = 68, OROW = 136;
constexpr int KT_BYTES = 64 * KROW * 2, VT_BYTES = 128 * VROW * 2, STAGE = KT_BYTES + VT_BYTES;
constexpr int O_OFF = 2 * STAGE, O_BYTES = 32 * OROW * 2;
constexpr int G_OFF = O_OFF + 8 * O_BYTES;
constexpr int ATT_LDS = G_OFF + 1024;
struct KV { u32x4 k0, k1, v0, v1; };
__device__ __forceinline__ void kv_load(KV& r, const bf16* Kg, const bf16* VT, int kvh, int s0, int tid) {
    asm volatile("" : "+v"(tid));
    const int key = tid >> 3, ch = tid & 7;
    const bf16* kp = Kg + (size_t)(s0 + key) * KVW + kvh * HD + ch * 16;
    r.k0 = *(const GAS u32x4*)kp; r.k1 = *(const GAS u32x4*)(kp + 8);
    r.v0 = *(const GAS u32x4*)(VT + (size_t)(kvh * HD + key) * S + s0 + ch * 8);
    r.v1 = *(const GAS u32x4*)(VT + (size_t)(kvh * HD + key + 64) * S + s0 + ch * 8);
}
__device__ __forceinline__ void kv_store(const KV& r, LAS unsigned char* stage, const LAS float* kgl, int tid) {
    asm volatile("" : "+v"(tid));
    const int key = tid >> 3, ch = tid & 7;
    LAS bf16* Kl = (LAS bf16*)stage; LAS bf16* Vl = (LAS bf16*)(stage + KT_BYTES);
    const u32x4 a = r.k0, b = r.k1;
    float v[16] = {bf_lo(a.x), bf_hi(a.x), bf_lo(a.y), bf_hi(a.y), bf_lo(a.z), bf_hi(a.z), bf_lo(a.w), bf_hi(a.w), bf_lo(b.x), bf_hi(b.x), bf_lo(b.y), bf_hi(b.y), bf_lo(b.z), bf_hi(b.z), bf_lo(b.w), bf_hi(b.w)};
    float ss = 0.f;
#pragma unroll
    for (int e = 0; e < 16; ++e) ss += v[e] * v[e];
    ss += __shfl_xor(ss, 1); ss += __shfl_xor(ss, 2); ss += __shfl_xor(ss, 4);
    const float rs = 1.0f / sqrtf(ss * (1.0f / HD) + EPS);
    const LAS f32x4* kg = (const LAS f32x4*)(kgl + ch * 16);
    const f32x4 g0 = kg[0], g1 = kg[1], g2 = kg[2], g3 = kg[3];
    u32x4 w0, w1;
    w0.x = cvt_pk_bf16(v[0] * rs * g0[0], v[1] * rs * g0[1]); w0.y = cvt_pk_bf16(v[2] * rs * g0[2], v[3] * rs * g0[3]); w0.z = cvt_pk_bf16(v[4] * rs * g1[0], v[5] * rs * g1[1]); w0.w = cvt_pk_bf16(v[6] * rs * g1[2], v[7] * rs * g1[3]);
    w1.x = cvt_pk_bf16(v[8] * rs * g2[0], v[9] * rs * g2[1]); w1.y = cvt_pk_bf16(v[10] * rs * g2[2], v[11] * rs * g2[3]); w1.z = cvt_pk_bf16(v[12] * rs * g3[0], v[13] * rs * g3[1]); w1.w = cvt_pk_bf16(v[14] * rs * g3[2], v[15] * rs * g3[3]);
    *(LAS u32x4*)(Kl + key * KROW + ch * 16) = w0; *(LAS u32x4*)(Kl + key * KROW + ch * 16 + 8) = w1;
    *(LAS u32x2*)(Vl + key * VROW + ch * 8) = (u32x2){r.v0.x, r.v0.y}; *(LAS u32x2*)(Vl + key * VROW + ch * 8 + 4) = (u32x2){r.v0.z, r.v0.w};
    *(LAS u32x2*)(Vl + (key + 64) * VROW + ch * 8) = (u32x2){r.v1.x, r.v1.y}; *(LAS u32x2*)(Vl + (key + 64) * VROW + ch * 8 + 4) = (u32x2){r.v1.z, r.v1.w};
}
__device__ __forceinline__ void unit_of(int u, int& kvh, int& qb) { kvh = (u >> 3) & 7; qb = ((u >> 6) << 3) + (u & 7); }
__device__ __forceinline__ void attn_phase(LAS unsigned char* lds, const bf16* Q, bf16* Gout, const bf16* Kg, const bf16* VT, const bf16* Z,
                                           const float* qgain, const float* kgain, const float* sink, int vcu, int G, int tid0) {
    int tid = tid0; const int wave = __builtin_amdgcn_readfirstlane(tid >> 6);
    int lane = tid & 63, lr = lane & 31, hh = lane >> 5;
    LAS float* gl = (LAS float*)(lds + G_OFF);
    LAS bf16* Ol = (LAS bf16*)(lds + O_OFF + wave * O_BYTES);
    if (tid < 128) gl[tid] = qgain[tid]; else if (tid < 256) gl[tid] = kgain[tid - 128];
    const int upw = (2048 + G - 1) / G;
    const int u_first = vcu * upw;
    u32x4 qraw[8]; KV kv;
    if (u_first < 2048) { int kvh, qb; unit_of(u_first, kvh, qb); const int t0 = qb * 64, c_lo = (2 - qb) > 0 ? (2 - qb) : 0;
        const bf16* qrow = Q + (size_t)(t0 + 32 * (wave & 1) + lr) * QW + (kvh * 4 + (wave >> 1)) * HD + 8 * hh;
#pragma unroll
        for (int j = 0; j < 8; ++j) qraw[j] = *(const GAS u32x4*)(qrow + 16 * j);
        kv_load(kv, Kg, VT, kvh, t0 - 128 + 64 * c_lo, tid); }
    __syncthreads();
    for (int ui = 0; ui < upw; ++ui) {
        const int u = u_first + ui; if (u >= 2048) break;
        asm volatile("" : "+v"(tid)); lane = tid & 63; lr = lane & 31; hh = lane >> 5;
        int kvh, qb; unit_of(u, kvh, qb);
        const int t0 = qb * 64, hq = kvh * 4 + (wave >> 1), tq = t0 + 32 * (wave & 1) + lr;
        const int c_lo = (2 - qb) > 0 ? (2 - qb) : 0, c_hi = (257 - qb) < 4 ? (257 - qb) : 4;
        const float slope2 = fast_exp2(-0.25f * (float)(hq + 1)) * LOG2E, sink2 = sink[hq] * LOG2E;
        bf16x8 qf[8];
        { float ss = 0.f;
#pragma unroll
          for (int j = 0; j < 8; ++j) { const float a0 = bf_lo(qraw[j].x), a1 = bf_hi(qraw[j].x), a2 = bf_lo(qraw[j].y), a3 = bf_hi(qraw[j].y), a4 = bf_lo(qraw[j].z), a5 = bf_hi(qraw[j].z), a6 = bf_lo(qraw[j].w), a7 = bf_hi(qraw[j].w);
              ss += (a0 * a0 + a1 * a1) + (a2 * a2 + a3 * a3) + (a4 * a4 + a5 * a5) + (a6 * a6 + a7 * a7); }
          ss += __shfl_xor(ss, 32);
          const float rs = (1.0f / sqrtf(ss * (1.0f / HD) + EPS)) * (0.08838834764831845f * LOG2E);
#pragma unroll
          for (int j = 0; j < 8; ++j) { const f32x4 g0 = *(const LAS f32x4*)(gl + 16 * j + 8 * hh), g1 = *(const LAS f32x4*)(gl + 16 * j + 8 * hh + 4);
              u32x4 w;
              w.x = cvt_pk_bf16(bf_lo(qraw[j].x) * rs * g0[0], bf_hi(qraw[j].x) * rs * g0[1]); w.y = cvt_pk_bf16(bf_lo(qraw[j].y) * rs * g0[2], bf_hi(qraw[j].y) * rs * g0[3]);
              w.z = cvt_pk_bf16(bf_lo(qraw[j].z) * rs * g1[0], bf_hi(qraw[j].z) * rs * g1[1]); w.w = cvt_pk_bf16(bf_lo(qraw[j].w) * rs * g1[2], bf_hi(qraw[j].w) * rs * g1[3]);
              qf[j] = __builtin_bit_cast(bf16x8, w); }
        }
        kv_store(kv, lds, gl + 128, tid);
        __syncthreads();
        float mrun = sink2, lrun = (hh == 0) ? 1.0f : 0.0f;
        f32x16 ot[4];
#pragma unroll
        for (int dt = 0; dt < 4; ++dt)
#pragma unroll
            for (int r = 0; r < 16; ++r) ot[dt][r] = 0.f;
        for (int c = c_lo; c <= c_hi; ++c) {
            const int s0 = t0 - 128 + 64 * c, st_i = (c - c_lo) & 1;
            asm volatile("" : "+v"(lr), "+v"(hh));
            if (c < c_hi) kv_load(kv, Kg, VT, kvh, s0 + 64, tid);
            const LAS bf16* Kl = (const LAS bf16*)(lds + st_i * STAGE); const LAS bf16* Vl = (const LAS bf16*)(lds + st_i * STAGE + KT_BYTES);
            f32x16 st[2];
#pragma unroll
            for (int kt = 0; kt < 2; ++kt) {
#pragma unroll
                for (int r = 0; r < 16; ++r) st[kt][r] = 0.f;
#pragma unroll
                for (int j = 0; j < 8; ++j) { const bf16x8 kf = *(const LAS bf16x8*)(Kl + (32 * kt + lr) * KROW + 16 * j + 8 * hh);
                    st[kt] = __builtin_amdgcn_mfma_f32_32x32x16_f16(kf, qf[j], st[kt], 0, 0, 0); } }
            const float fb = (float)(s0 + 4 * hh - tq);
            float mx = -INFINITY;
#pragma unroll
            for (int kt = 0; kt < 2; ++kt)
#pragma unroll
                for (int r = 0; r < 16; ++r) { const float ax = fabsf(fb + (float)(32 * kt + 8 * (r >> 2) + (r & 3)));
                    float v = st[kt][r] - slope2 * ax; v = (ax > 128.0f) ? -INFINITY : v; st[kt][r] = v; mx = fmaxf(mx, v); }
            mx = fmaxf(mx, __shfl_xor(mx, 32));
            const float mnew = fmaxf(mrun, mx), alpha = fast_exp2(mrun - mnew);
            mrun = mnew; lrun *= alpha;
#pragma unroll
            for (int dt = 0; dt < 4; ++dt)
#pragma unroll
                for (int r = 0; r < 16; ++r) ot[dt][r] *= alpha;
            bf16x8 pk[2][2];
#pragma unroll
            for (int kt = 0; kt < 2; ++kt)
#pragma unroll
                for (int jj = 0; jj < 2; ++jj) { float p[8];
#pragma unroll
                    for (int e = 0; e < 8; ++e) { p[e] = fast_exp2(st[kt][8 * jj + e] - mnew); lrun += p[e]; }
                    u32x4 w; w.x = cvt_pk_bf16(p[0], p[1]); w.y = cvt_pk_bf16(p[2], p[3]); w.z = cvt_pk_bf16(p[4], p[5]); w.w = cvt_pk_bf16(p[6], p[7]);
                    pk[kt][jj] = __builtin_bit_cast(bf16x8, w); }
#pragma unroll
            for (int kt = 0; kt < 2; ++kt)
#pragma unroll
                for (int jj = 0; jj < 2; ++jj)
#pragma unroll
                    for (int dt = 0; dt < 4; ++dt) { const LAS bf16* vp = Vl + (32 * dt + lr) * VROW + 32 * kt + 16 * jj + 4 * hh;
                        const u32x2 a0 = *(const LAS u32x2*)vp, a1 = *(const LAS u32x2*)(vp + 8);
                        const bf16x8 vf = __builtin_bit_cast(bf16x8, (u32x4){a0.x, a0.y, a1.x, a1.y});
                        ot[dt] = __builtin_amdgcn_mfma_f32_32x32x16_f16(vf, pk[kt][jj], ot[dt], 0, 0, 0); }
            if (c < c_hi) kv_store(kv, lds + (st_i ^ 1) * STAGE, gl + 128, tid);
            __syncthreads();
        }
        if (ui + 1 < upw && u + 1 < 2048) {
            int kvh2, qb2; unit_of(u + 1, kvh2, qb2); const int t02 = qb2 * 64, c_lo2 = (2 - qb2) > 0 ? (2 - qb2) : 0;
            const bf16* qrow = Q + (size_t)(t02 + 32 * (wave & 1) + lr) * QW + (kvh2 * 4 + (wave >> 1)) * HD + 8 * hh;
#pragma unroll
            for (int j = 0; j < 8; ++j) qraw[j] = *(const GAS u32x4*)(qrow + 16 * j);
            kv_load(kv, Kg, VT, kvh2, t02 - 128 + 64 * c_lo2, tid); }
        lrun += __shfl_xor(lrun, 32);
        const float inv = 1.0f / lrun;
#pragma unroll
        for (int dt = 0; dt < 4; ++dt)
#pragma unroll
            for (int g4 = 0; g4 < 4; ++g4) { u32x2 w; w.x = cvt_pk_bf16(ot[dt][4 * g4 + 0] * inv, ot[dt][4 * g4 + 1] * inv); w.y = cvt_pk_bf16(ot[dt][4 * g4 + 2] * inv, ot[dt][4 * g4 + 3] * inv);
                *(LAS u32x2*)(Ol + lr * OROW + 32 * dt + 8 * g4 + 4 * hh) = w; }
        asm volatile("s_waitcnt lgkmcnt(0)" ::: "memory");
        { const int rsub = lane >> 4, chunk = lane & 15; const size_t gbase = (size_t)(t0 + 32 * (wave & 1)) * QW + hq * HD + 8 * chunk;
          u32x4 zz[8];
#pragma unroll
          for (int i = 0; i < 8; ++i) zz[i] = *(const GAS u32x4*)(Z + gbase + (size_t)(4 * i + rsub) * QW);
#pragma unroll
          for (int i = 0; i < 8; ++i) { const u32x4 o = *(const LAS u32x4*)(Ol + (4 * i + rsub) * OROW + 8 * chunk); const u32x4 z = zz[i];
              u32x4 w;
              w.x = cvt_pk_bf16(bf_lo(o.x) * siluf_(bf_lo(z.x)), bf_hi(o.x) * siluf_(bf_hi(z.x))); w.y = cvt_pk_bf16(bf_lo(o.y) * siluf_(bf_lo(z.y)), bf_hi(o.y) * siluf_(bf_hi(z.y)));
              w.z = cvt_pk_bf16(bf_lo(o.z) * siluf_(bf_lo(z.z)), bf_hi(o.z) * siluf_(bf_hi(z.z))); w.w = cvt_pk_bf16(bf_lo(o.w) * siluf_(bf_lo(z.w)), bf_hi(o.w) * siluf_(bf_hi(z.w)));
              *(GAS u32x4*)(Gout + gbase + (size_t)(4 * i + rsub) * QW) = w; } }
    }
    __syncthreads();
}
}

struct Args { const float* in[15]; float* out; unsigned char* ws; int ph_lo, ph_hi; };
constexpr int N_PHASES = 1 + DEPTH * 7;

__global__ void __launch_bounds__(512, 2) fwd_kernel(Args args) {
    extern __shared__ __attribute__((aligned(16))) unsigned char lds_raw[];
    LAS unsigned char* lds = (LAS unsigned char*)lds_raw;
    volatile LAS unsigned* MISC = (volatile LAS unsigned*)(lds + MISC_OFF);
    const int tid = threadIdx.x, wave = __builtin_amdgcn_readfirstlane(tid >> 6);
    const int G = gridDim.x, bx = blockIdx.x;
    unsigned* ctl = (unsigned*)(args.ws + WS_CTL);
    for (int u = tid; u < (LDS_BYTES - LDSCTL_OFF) / 4; u += 512) ((LAS unsigned*)(lds + LDSCTL_OFF))[u] = 0u;
    __syncthreads();
    const int lo = args.ph_lo, hi = args.ph_hi;
    XcdBarrier bar; bar.bar = ctl + CW_BAR; bar.x = 0; bar.st = MISC + 8; bar.wave = wave;
    if (hi - lo > 1) bar = xcd_barrier_post(ctl + CW_BAR, MISC + 8, wave);
#define IN(k) (lo <= (k) && (k) < hi)
#define BOTH(k) (IN(k) && IN((k) + 1))
#define GRID_BAR(k) do { if (BOTH(k)) { XcdBarrier b2 = bar; LAUNDER_S(b2.bar); xcd_barrier(b2); } } while (0)

#define LAUNDER_S(x) asm volatile("" : "+s"(x))
#define LAUNDER_V(x) asm volatile("" : "+v"(x))
#define PHASE_BASES() unsigned char* wsp = args.ws; LAUNDER_S(wsp); int Gp = G, bxp = bx; LAUNDER_S(Gp); LAUNDER_S(bxp); int tidp = wave * 64 + lane_id(); LAUNDER_V(tidp); \
        const int lanep = tidp & 63, wavep = __builtin_amdgcn_readfirstlane(tidp >> 6); \
        const int vcu = (Gp % 8 == 0) ? (bxp % 8) * (Gp / 8) + bxp / 8 : bxp; const int gw = vcu * 8 + wavep, NGW = Gp * 8; (void)gw; (void)NGW; (void)wsp; (void)lanep

    if (IN(0)) {
        PHASE_BASES();
        LAS float* scr = (LAS float*)(lds + wavep * 16384);
        REPEAT(PROBE_PRO) {
        if ((I8_AIN_MASK & 0x3) != 0x3) {
#pragma nounroll
            for (int b = 0; b < 2; ++b) if (!((launder_i(I8_AIN_MASK) >> b) & 1))
                transpose_batch(args.in[3] + (size_t)b * D * AIN, 1, D, AIN, (bf16*)(wsp + WS_WAIN) + (size_t)b * D * AIN, 1, scr, gw, NGW, lanep, 0, -1, args.in[2] + (size_t)b * 2 * D, 2 * D); }
        transpose_batch(args.in[7], 2, QW, D, (bf16*)(wsp + WS_WAOUT), 0, scr, gw, NGW, lanep);
        if ((I8_PIN_MASK & 0x3) != 0x3) {
#pragma nounroll
            for (int b = 0; b < 2; ++b) if (!((launder_i(I8_PIN_MASK) >> b) & 1))
                transpose_batch(args.in[8] + (size_t)b * D * 2 * POOLW, 1, D, 2 * POOLW, (bf16*)(wsp + WS_WPIN) + (size_t)b * D * 2 * POOLW, 0, scr, gw, NGW, lanep, POOLW / 32, POOLW / 32, args.in[2] + D + (size_t)b * 2 * D, 2 * D); }
        {
          const GAS float* src = (const GAS float*)args.in[8]; bf16* dstb = (bf16*)(wsp + WS_WINV);
          for (int row = gw; row < 2 * D; row += NGW) { const int Lx = row / D, k = row - Lx * D;
              const float gg = args.in[2][(size_t)(2 * Lx + 1) * D + k]; const GAS f32x4* sp = (const GAS f32x4*)(src + (size_t)row * (2 * POOLW)) + lanep;
#pragma unroll
              for (int jj = 0; jj < 4; ++jj) { f32x4 v[8];
#pragma unroll
                  for (int i = 0; i < 8; ++i) v[i] = sp[(jj * 8 + i) * 64];
                  GAS u32x2* dp = (GAS u32x2*)(dstb + (((size_t)Lx * 4 + jj) * D + k) * GW) + lanep;
#pragma unroll
                  for (int i = 0; i < 8; ++i) { u32x2 w; w.x = cvt_pk_bf16(v[i][0] * gg, v[i][1] * gg); w.y = cvt_pk_bf16(v[i][2] * gg, v[i][3] * gg); dp[i * 64] = w; } } } }
        transpose_batch(args.in[9], 8, GW, GW, (bf16*)(wsp + WS_WGRP), 0, scr, gw, NGW, lanep);
        transpose_batch(args.in[11], 2, POOLW, D, (bf16*)(wsp + WS_WPOUT), 0, scr, gw, NGW, lanep);
        if ((I8_GATE_MASK & 0xF) != 0xF) {
#pragma nounroll
            for (int b = 0; b < 4; ++b) if (!((launder_i(I8_GATE_MASK) >> b) & 1))
                transpose_batch(args.in[13] + (size_t)b * D * D, 1, D, D, (bf16*)(wsp + WS_WGATE) + (size_t)b * D * D, 0, scr, gw, NGW, lanep, 0, -1, args.in[12] + (size_t)b * D, D, (FP8_GATE_MASK >> b) & 1u); }
        if (I8_GATE_MASK) { __syncthreads(); i8w_fused(args.in[13], 4, I8_GATE_MASK, D, D, 0, D / 32, 0, args.in[12], D, wsp + WS_WGATE, (size_t)D * D * 2, (unsigned*)(wsp + WS_CTL + CTL_CMAX), D, lds, vcu, Gp, tidp); }
        if (I8_AIN_MASK) { __syncthreads(); i8w_fused(args.in[3], 2, I8_AIN_MASK, D, AIN, 0, AIN / 32, 1, args.in[2], 2 * D, wsp + WS_WAIN, (size_t)D * AIN * 2, (unsigned*)(wsp + WS_CTL + CTL_CMAXA), AIN, lds, vcu, Gp, tidp, 128); }
        if (I8_PIN_MASK) { __syncthreads(); i8w_fused(args.in[8], 2, I8_PIN_MASK, D, 2 * POOLW, POOLW / 32, POOLW / 32, 0, args.in[2] + D, 2 * D, wsp + WS_WPIN, (size_t)D * 2 * POOLW * 2, (unsigned*)(wsp + WS_CTL + CTL_CMAXP), 2 * POOLW, lds, vcu, Gp, tidp); __syncthreads(); }
        transpose_batch(args.in[14], 4, PLE, D, (bf16*)(wsp + WS_WPROJ), 0, scr, gw, NGW, lanep);
        {
          constexpr int n4 = DEPTH * S * PLE / 4; const GAS f32x4* src = (const GAS f32x4*)args.in[1]; GAS u32x2* dst = (GAS u32x2*)(wsp + WS_PBF);
          for (int base = gw * 512; base < n4; base += NGW * 512) { f32x4 v[8];
#pragma unroll
              for (int i = 0; i < 8; ++i) v[i] = src[base + i * 64 + lanep];
#pragma unroll
              for (int i = 0; i < 8; ++i) { u32x2 w; w.x = cvt_pk_bf16(v[i][0], v[i][1]); w.y = cvt_pk_bf16(v[i][2], v[i][3]); dst[base + i * 64 + lanep] = w; } } }
        }
        GRID_BAR(0);
    }

    for (int L = 0; L < DEPTH; ++L) {
        const int pb = 1 + L * 7, jl = L >> 1; const bool is_attn = !(L & 1);
        if (IN(pb + 0) && L == 0) {
            PHASE_BASES();
            REPEAT(PROBE_NORM) xg_rows(args.in[0], (bf16*)(wsp + WS_H), (pg8::rss_t*)(wsp + WS_CTL + CTL_RSS), (I8_AIN_MASK & 1) ? (unsigned char*)(wsp + WS_ACT + ACT_XI8) : (unsigned char*)nullptr, gw, NGW, lanep);
            {
                constexpr int off0 = (I8_PIN_MASK & 1) ? POOLW : 0, off1 = (I8_PIN_MASK & 2) ? POOLW : 0;
                bf16* WP = (bf16*)(wsp + WS_WPIN) + (size_t)off0 * D;
                pg8::Gemm g2{(const bf16*)(wsp + WS_WGRP), (const bf16*)(wsp + WS_WINV), GW, GW, 2 * 4 * GW, D, GW, 0, 0, 3, D * GW};
                pg8::StaticOrder so2; so2.init(2 * 4 * GW, D, Gp, bxp);
                pg8::EpiSplit E2{WP, WP, WP, D, D, D, 1 << 30, 1 << 30, 5, (POOLW + off1 - off0) * D, nullptr, 0, I8_PIN_MASK ? (unsigned*)(wsp + WS_CTL + CTL_CMAXP) : (unsigned*)nullptr, 5, POOLW, nullptr, nullptr};
                pg8::gemm_phase<pg8::EpiSplit>(lds, g2, so2, E2, tidp);
            }
            GRID_BAR(pb + 0);
        }
        if (IN(pb + 1)) {
            PHASE_BASES();
            const bf16* H = (const bf16*)(wsp + WS_H); unsigned char* ACT = wsp + WS_ACT;
            const pg8::rss_t* rssA = (const pg8::rss_t*)(wsp + WS_CTL + CTL_RSS) + (size_t)(2 * L) * S;
            { bf16* PP = (bf16*)(wsp + WS_PP);
              pg8::Gemm g{(bf16*)(wsp + WS_PBF) + (size_t)L * S * PLE, (bf16*)(wsp + WS_WPROJ) + (size_t)L * D * PLE, PLE, PLE, S, D, PLE, 0, 0, 0, 0};
              pg8::StaticOrder so; so.init(S, D, Gp, bxp);
              pg8::EpiSplit E{PP, PP, PP, D, D, D, 1 << 30, 1 << 30, 0, 0, nullptr, 0, nullptr, 0, 0, nullptr, nullptr};
              pg8::gemm_phase<pg8::EpiSplit>(lds, g, so, E, tidp); }
            if (is_attn && I8_AIN_MASK != 0 && ((I8_AIN_MASK >> jl) & 1)) {
                const bf16* XI8 = (const bf16*)(ACT + ACT_XI8); const bf16* W8 = (const bf16*)(wsp + WS_WAIN) + (size_t)jl * AIN * D;
                const unsigned* cmx = (const unsigned*)(wsp + WS_CTL + CTL_CMAXA) + (size_t)jl * AIN;
                const pg8::rss_t* rssQ = (const pg8::rss_t*)(wsp + WS_CTL + CTL_RSS) + (size_t)(L == 0 ? 0 : 2 * L - 1) * S;
                { pg8::Gemm g{XI8, W8, D / 2, D / 2, S, 9216, D / 2, 0, 0, 0, 0}; pg8::StaticOrder so; so.init(S, 9216, Gp, bxp);
                  pg8::EpiSplit E{(bf16*)(ACT + ACT_Q), (bf16*)(ACT + ACT_K), (bf16*)(ACT + ACT_Z), QW, KVW, QW, 16, 20, 0, 0, rssA, 1, nullptr, 0, 0, cmx, rssQ};
                  pg8::gemm_phase<pg8::EpiSplit, true, 2>(lds, g, so, E, tidp); }
                { bf16* AVT = (bf16*)(ACT + ACT_VT);
                  pg8::Gemm g{W8 + (size_t)9216 * (D / 2), XI8, D / 2, D / 2, KVW, S, D / 2, 0, 0, 0, 0}; pg8::StaticOrder so; so.init(KVW, S, Gp, bxp);
                  pg8::EpiSplit E{AVT, AVT, AVT, S, S, S, 1 << 30, 1 << 30, 0, 0, rssA, 2, nullptr, 0, 0, cmx + 9216, rssQ};
                  pg8::gemm_phase<pg8::EpiSplit, true, 2>(lds, g, so, E, tidp); }
            } else if (is_attn) {
                const bf16* W = (const bf16*)(wsp + WS_WAIN) + (size_t)jl * AIN * D;
                { pg8::Gemm g{H, W, D, D, S, 9216, D, 0, 0, 0, 0}; pg8::StaticOrder so; so.init(S, 9216, Gp, bxp);
                  pg8::EpiSplit E{(bf16*)(ACT + ACT_Q), (bf16*)(ACT + ACT_K), (bf16*)(ACT + ACT_Z), QW, KVW, QW, 16, 20, 0, 0, rssA, 1, nullptr, 0, 0, nullptr, nullptr};
                  pg8::gemm_phase<pg8::EpiSplit>(lds, g, so, E, tidp); }
                { bf16* AVT = (bf16*)(ACT + ACT_VT);
                  pg8::Gemm g{W + (size_t)9216 * D, H, D, D, KVW, S, D, 0, 0, 0, 0}; pg8::StaticOrder so; so.init(KVW, S, Gp, bxp);
                  pg8::EpiSplit E{AVT, AVT, AVT, S, S, S, 1 << 30, 1 << 30, 0, 0, rssA, 2, nullptr, 0, 0, nullptr, nullptr};
                  pg8::gemm_phase<pg8::EpiSplit>(lds, g, so, E, tidp); }
            } else if (I8_PIN_MASK != 0 && ((I8_PIN_MASK >> jl) & 1)) {
                bf16* PZ = (bf16*)(ACT + ACT_PZ);
                const bf16* XI8 = (const bf16*)(ACT + ACT_XI8); const bf16* W8 = (const bf16*)(wsp + WS_WPIN) + (size_t)jl * 2 * POOLW * D;
                const unsigned* cmx = (const unsigned*)(wsp + WS_CTL + CTL_CMAXP) + (size_t)jl * 2 * POOLW;
                const pg8::rss_t* rssQ = (const pg8::rss_t*)(wsp + WS_CTL + CTL_RSS) + (size_t)(2 * L - 1) * S;
                pg8::Gemm g{XI8, W8, D / 2, D / 2, S, 2 * POOLW, D / 2, 0, 0, 0, 0}; pg8::StaticOrder so; so.init(S, 2 * POOLW, Gp, bxp);
                pg8::EpiSplit E{(bf16*)(ACT + ACT_V), PZ, PZ, POOLW, POOLW, POOLW, 32, 1 << 30, 0, 0, rssA, 1, nullptr, 0, 0, cmx, rssQ};
                pg8::gemm_phase<pg8::EpiSplit, true, 2>(lds, g, so, E, tidp);
            } else {
                bf16* PZ = (bf16*)(ACT + ACT_PZ);
                pg8::Gemm g{H, (const bf16*)(wsp + WS_WPIN) + (size_t)jl * 2 * POOLW * D, D, D, S, 2 * POOLW, D, 0, 0, 0, 0}; pg8::StaticOrder so; so.init(S, 2 * POOLW, Gp, bxp);
                pg8::EpiSplit E{(bf16*)(ACT + ACT_V), PZ, PZ, POOLW, POOLW, POOLW, 32, 1 << 30, 0, 0, rssA, 1, nullptr, 0, 0, nullptr, nullptr};
                pg8::gemm_phase<pg8::EpiSplit>(lds, g, so, E, tidp);
            }
            GRID_BAR(pb + 1);
        }
        if (IN(pb + 2)) {
            PHASE_BASES();
            unsigned char* ACT = wsp + WS_ACT;
            if (is_attn) REPEAT(PROBE_ATT) att::attn_phase(lds, (const bf16*)(ACT + ACT_Q), (bf16*)(ACT + ACT_G), (const bf16*)(ACT + ACT_K), (const bf16*)(ACT + ACT_VT), (const bf16*)(ACT + ACT_Z),
                                         args.in[4] + jl * HD, args.in[5] + jl * HD, args.in[6] + jl * 32, vcu, Gp, tidp);
            if (L == 0 && I8_PIN_MASK) {
#pragma nounroll
                for (int b = 0; b < 2; ++b) if ((launder_i(I8_PIN_MASK) >> b) & 1) { unsigned char* slot = wsp + WS_WPIN + (size_t)b * 2 * POOLW * D * 2;
                    wq_rows((const bf16*)(slot + (size_t)POOLW * D * 2), slot, (const unsigned*)(wsp + WS_CTL + CTL_CMAXP) + (size_t)b * 2 * POOLW, gw, NGW, lanep); } }
            if (!is_attn) REPEAT(PROBE_POOL) poolgate_phase((const bf16*)(ACT + ACT_V), (const bf16*)(ACT + ACT_PZ), args.in[10] + (size_t)jl * POOLW, (bf16*)(ACT + ACT_DP), vcu, Gp, tidp);
            GRID_BAR(pb + 2);
        }
        if (IN(pb + 4)) {
            PHASE_BASES();
            unsigned char* ACT = wsp + WS_ACT;
            const int Kc = is_attn ? QW : POOLW;
            pg8::Gemm g{is_attn ? (const bf16*)(ACT + ACT_G) : (const bf16*)(ACT + ACT_DP), is_attn ? (const bf16*)(wsp + WS_WAOUT) + (size_t)jl * D * QW : (const bf16*)(wsp + WS_WPOUT) + (size_t)jl * D * POOLW, Kc, Kc, S, D, Kc, 0, 0, 0, 0};
            pg8::StaticOrder so; so.init(S, D, Gp, bxp);
            pg8::EpiRes E{(const bf16*)(wsp + WS_H), (bf16*)(wsp + WS_H1), (pg8::rss_t*)(wsp + WS_CTL + CTL_RSS) + (size_t)(2 * L + 1) * S, D, (((FP8_GATE_MASK | I8_GATE_MASK) >> L) & 1) ? (unsigned char*)ACT : (unsigned char*)nullptr, ((I8_GATE_MASK >> L) & 1) ? 2 : 1,
                          (const pg8::rss_t*)(wsp + WS_CTL + CTL_RSS) + (size_t)(2 * L) * S};
            pg8::gemm_phase<pg8::EpiRes>(lds, g, so, E, tidp);
            GRID_BAR(pb + 4);
        }
        if (IN(pb + 6)) {
            PHASE_BASES();
            pg8::StaticOrder so; so.init(S, D, Gp, bxp);
            const bool more = (L + 1 < DEPTH); const bool i8 = ((I8_GATE_MASK >> L) & 1) != 0; const bool f8 = !i8 && ((FP8_GATE_MASK >> L) & 1) != 0;
            pg8::EpiGate E{(const bf16*)(wsp + WS_H1), (const bf16*)(wsp + WS_PP), (const pg8::rss_t*)(wsp + WS_CTL + CTL_RSS) + (size_t)(2 * L + 1) * S,
                           more ? (bf16*)(wsp + WS_H) : (bf16*)nullptr, (pg8::rss_t*)(wsp + WS_CTL + CTL_RSS) + (size_t)(more ? 2 * L + 2 : 0) * S, args.out, D, f8 ? (1.0f / 512.0f) : 1.0f,
                           i8 ? (const unsigned*)(wsp + WS_CTL + CTL_CMAX) + (size_t)L * D : (const unsigned*)nullptr, (const pg8::rss_t*)(wsp + WS_CTL + CTL_RSS) + (size_t)(2 * L) * S,
                           (more && (((L & 1) && ((I8_AIN_MASK >> ((L + 1) >> 1)) & 1)) || (!(L & 1) && ((I8_PIN_MASK >> (L >> 1)) & 1)))) ? (unsigned char*)(wsp + WS_ACT + ACT_XI8) : (unsigned char*)nullptr};
            if (I8_GATE_MASK != 0 && i8) {
                pg8::Gemm g{(const bf16*)(wsp + WS_ACT), (const bf16*)(wsp + WS_WGATE) + (size_t)L * D * D, D / 2, D / 2, S, D, D / 2, 0, 0, 0, 0};
                pg8::gemm_phase<pg8::EpiGate, true, 2>(lds, g, so, E, tidp);
            }
            if (FP8_GATE_MASK != 0 && f8) {
                pg8::Gemm g{(const bf16*)(wsp + WS_ACT), (const bf16*)(wsp + WS_WGATE) + (size_t)L * D * D, D / 2, D / 2, S, D, D / 2, 0, 0, 0, 0};
                pg8::gemm_phase<pg8::EpiGate, true, 1>(lds, g, so, E, tidp);
            }
            if (((FP8_GATE_MASK | I8_GATE_MASK) & 0xF) != 0xF && !f8 && !i8) {
                pg8::Gemm g{(const bf16*)(wsp + WS_H1), (const bf16*)(wsp + WS_WGATE) + (size_t)L * D * D, D, D, S, D, D, 0, 0, 0, 0};
                pg8::gemm_phase<pg8::EpiGate>(lds, g, so, E, tidp);
            }
            GRID_BAR(pb + 6);
        }
    }
#undef IN
#undef BOTH
#undef GRID_BAR
}

extern "C" void kernel_launch(void* const* d_in, const int* in_sizes, int n_in, void* d_out, int out_size, void* d_ws, size_t ws_size, hipStream_t stream) {
    static int grid = 0;
    if (grid == 0) {
        if (n_in != 15 || in_sizes[0] != S * D || out_size != S * D || ws_size < WS_END) {
            fprintf(stderr, "kernel_launch: unexpected shapes / workspace (n_in %d, in0 %d, out %d, ws %zu, need %zu); nothing launched\n", n_in, n_in > 0 ? in_sizes[0] : -1, out_size, ws_size, (size_t)WS_END); grid = -1; return; }
        int dev = 0, cus = 0, per_cu = 0;
        if (hipGetDevice(&dev) != hipSuccess || hipDeviceGetAttribute(&cus, hipDeviceAttributeMultiprocessorCount, dev) != hipSuccess) { grid = -1; return; }
        if (hipFuncSetAttribute((const void*)fwd_kernel, hipFuncAttributeMaxDynamicSharedMemorySize, LDS_BYTES) != hipSuccess) { fprintf(stderr, "kernel_launch: hipFuncSetAttribute failed\n"); grid = -1; return; }
        if (hipOccupancyMaxActiveBlocksPerMultiprocessor(&per_cu, (const void*)fwd_kernel, 512, LDS_BYTES) != hipSuccess || per_cu < 1)
            fprintf(stderr, "kernel_launch: note: occupancy query reports %d workgroups per CU\n", per_cu);
        (void)hipGetLastError();
        grid = cus;
    }
    if (grid < 0) return;
    if (hipMemsetAsync((char*)d_ws + WS_CTL, 0, CTL_ZERO_BYTES, stream) != hipSuccess) return;
    Args a{};
    for (int i = 0; i < 15; ++i) a.in[i] = (const float*)d_in[i];
    a.out = (float*)d_out; a.ws = (unsigned char*)d_ws;
#if MK_ONE_LAUNCH
    a.ph_lo = 0; a.ph_hi = N_PHASES;
    hipLaunchKernelGGL(fwd_kernel, dim3(grid), dim3(512), LDS_BYTES, stream, a);
#else
    for (int k = 0; k < N_PHASES; ++k) { a.ph_lo = k; a.ph_hi = k + 1; hipLaunchKernelGGL(fwd_kernel, dim3(grid), dim3(512), LDS_BYTES, stream, a); }
#endif
}
```
